# Optimizing an MI355X kernel written in HIP

```python
import jax, jax.numpy as jnp
from jax import lax
import numpy as np

D_MODEL = 2048
BATCH = 16
SEQ = 256
DEPTH = 4
DEC_BATCH = 2
DEC_SEQ = 4096
PAST_LEN = 512

GRID_W = 64
N_EVEN = (DEPTH + 1) // 2
N_ODD = DEPTH // 2
POOL_WIDTH = D_MODEL // 2
POOL_GROUPS = 4
POOL_GC = POOL_WIDTH // POOL_GROUPS
POOL_WINDOWS = (2, 4, 8, 16)
RET_WIDTH = D_MODEL // 2
H_RET = 8
DK_RET = RET_WIDTH // H_RET
DV_RET = RET_WIDTH // H_RET
ROPE_BASE = 10000.0
H_GLA = 4
GLA_DK_TOTAL = D_MODEL // 2
GLA_DV_TOTAL = D_MODEL
DK_GLA = GLA_DK_TOTAL // H_GLA
DV_GLA = GLA_DV_TOTAL // H_GLA
GLA_GATE_RANK = 16
GLA_TAU = 16.0
D_FF = 5632
CONV_W = 3
CHUNK = 64
EPS = 1e-6
EVEN_IN = POOL_WIDTH + 4 * RET_WIDTH
ODD_IN = 2 * GLA_DK_TOTAL + 2 * GLA_DV_TOTAL

kernel_name = "hybrid_pool_retention_gla_diffusion_step"


def _rms_norm(x, g):
    xf = x.astype(jnp.float32)
    xf = xf * lax.rsqrt(jnp.mean(xf * xf, axis=-1, keepdims=True) + EPS)
    return (xf * g.astype(jnp.float32)).astype(x.dtype)


def _head_rms(o, g):
    B, T, H, Dv = o.shape
    of = o.astype(jnp.float32)
    of = of * lax.rsqrt(jnp.mean(of * of, axis=-1, keepdims=True) + EPS)
    return (of.reshape(B, T, H * Dv) * g.astype(jnp.float32)).astype(o.dtype)


def _rope_tables(T):
    rows = T // GRID_W
    r = jnp.repeat(jnp.arange(rows), GRID_W).astype(jnp.float32)
    col = jnp.tile(jnp.arange(GRID_W), rows).astype(jnp.float32)
    nf = DK_RET // 4
    inv = ROPE_BASE ** (-jnp.arange(nf, dtype=jnp.float32) / nf)
    ang = jnp.stack([r[:, None] * inv, col[:, None] * inv], axis=1)
    return jnp.cos(ang), jnp.sin(ang)


def _apply_rope(x, cos, sin):
    B, T, H, Dk = x.shape
    nf = Dk // 4
    xr = x.astype(jnp.float32).reshape(B, T, H, 2, 2, nf)
    x1, x2 = xr[..., 0, :], xr[..., 1, :]
    c = cos[None, :, None]
    s = sin[None, :, None]
    out = jnp.stack([x1 * c - x2 * s, x1 * s + x2 * c], axis=-2)
    return out.reshape(B, T, H, Dk).astype(x.dtype)


def _chunk_scan(q, k, v, logg, s0):
    B, T, H, Dk = q.shape
    Dv = v.shape[-1]
    C = CHUNK
    N = T // C
    qf = q.astype(jnp.float32).reshape(B, N, C, H, Dk)
    kf = k.astype(jnp.float32).reshape(B, N, C, H, Dk)
    vf = v.astype(jnp.float32).reshape(B, N, C, H, Dv)
    lg = logg.astype(jnp.float32).reshape(logg.shape[0], N, C, H, logg.shape[-1])
    G = jnp.cumsum(lg, axis=2)
    Gt = G[:, :, -1:]
    qd = qf * jnp.exp(G)
    kd = kf * jnp.exp(-G)
    kt = kf * jnp.exp(Gt - G)
    mask = jnp.tril(jnp.ones((C, C), dtype=bool))
    A = jnp.einsum('bnihd,bnjhd->bnhij', qd, kd)
    A = jnp.where(mask, A, 0.0)
    o_intra = jnp.einsum('bnhij,bnjhe->bnihe', A, vf)
    dec = jnp.broadcast_to(jnp.exp(Gt[:, :, 0])[..., None], (B, N, H, Dk, 1))

    def step(S, inp):
        dec_n, kt_n, v_n, qd_n = inp
        o_n = jnp.einsum('bchd,bhde->bche', qd_n, S)
        S = dec_n * S + jnp.einsum('bchd,bche->bhde', kt_n, v_n)
        return S, o_n

    xs = (jnp.moveaxis(dec, 1, 0), jnp.moveaxis(kt, 1, 0), jnp.moveaxis(vf, 1, 0), jnp.moveaxis(qd, 1, 0))
    S_fin, o_inter = lax.scan(step, s0.astype(jnp.float32), xs)
    o = o_intra + jnp.moveaxis(o_inter, 0, 1)
    return o.reshape(B, T, H, Dv).astype(v.dtype), S_fin


def _bidir_scan(q, k, v, logg_f, logg_b, s0_f, s0_b):
    flip = lambda a: jnp.flip(a, axis=1)
    o_f, s_f = _chunk_scan(q, k, v, logg_f, s0_f)
    o_b, s_b = _chunk_scan(flip(q), flip(k), flip(v), flip(logg_b), s0_b)
    return o_f + flip(o_b), s_f, s_b


def _pool_mixer(u, w, scale):
    B, T, _ = u.shape
    uf = u.astype(jnp.float32).reshape(B, T, POOL_GROUPS, POOL_GC)
    cs = jnp.pad(jnp.cumsum(uf, axis=1), ((0, 0), (1, 0), (0, 0), (0, 0)))
    t = jnp.arange(T)
    outs = []
    for gi, win in enumerate(POOL_WINDOWS):
        lo = jnp.clip(t - win // 2, 0, T)
        hi = jnp.clip(t + win - win // 2, 0, T)
        csg = cs[:, :, gi]
        s = jnp.take(csg, hi, axis=1) - jnp.take(csg, lo, axis=1)
        outs.append(s / (hi - lo).astype(jnp.float32)[None, :, None])
    pooled = jnp.stack(outs, axis=2) - uf
    y = jnp.einsum('btgc,gcd->btgd', pooled, w.astype(jnp.float32))
    return (y.reshape(B, T, POOL_WIDTH) * scale.astype(jnp.float32)).astype(u.dtype)


def _dwconv3(a, w, b):
    ap = jnp.pad(a, ((0, 0), (1, 1), (0, 0)))
    return ap[:, :-2] * w[0] + ap[:, 1:-1] * w[1] + ap[:, 2:] * w[2] + b


def _trunk(x, cvec, s_ret, s_gla, rope, ada_w, ada_b, norm1_g, norm2_g, even_w_in, pool_w, pool_scale,
           ret_decay, ret_norm_g, even_w_out, odd_w_in, gla_gw1, gla_gw2, gla_gb, gla_norm_g, odd_w_out,
           ffn_w_up, ffn_conv_w, ffn_conv_b, ffn_w_down, final_g):
    B, T, _ = x.shape
    ret_states, gla_states = [], []
    for l in range(DEPTH):
        mod = (jax.nn.silu(cvec) @ ada_w[l] + ada_b[l])[:, None, :]
        sh1, sc1, g1, sh2, sc2, g2 = jnp.split(mod, 6, axis=-1)
        h = _rms_norm(x, norm1_g[l]) * (1 + sc1) + sh1
        if l % 2 == 0:
            i = l // 2
            proj = h @ even_w_in[i]
            u_pool, q, k, v, g = jnp.split(
                proj, [POOL_WIDTH, POOL_WIDTH + RET_WIDTH, POOL_WIDTH + 2 * RET_WIDTH, POOL_WIDTH + 3 * RET_WIDTH], axis=-1)
            q = q.reshape(B, T, H_RET, DK_RET)
            k = k.reshape(B, T, H_RET, DK_RET) * (DK_RET ** -0.5)
            v = v.reshape(B, T, H_RET, DV_RET)
            if rope is not None:
                q = _apply_rope(q, rope[0], rope[1])
                k = _apply_rope(k, rope[0], rope[1])
            logg = jax.nn.log_sigmoid(ret_decay[i].astype(jnp.float32))
            lf = jnp.broadcast_to(logg[0][None, None, :, None], (1, T, H_RET, 1))
            lb = jnp.broadcast_to(logg[1][None, None, :, None], (1, T, H_RET, 1))
            o, sf, sb = _bidir_scan(q, k, v, lf, lb, s_ret[:, i, 0], s_ret[:, i, 1])
            o = _head_rms(o, ret_norm_g[i]) * jax.nn.silu(g)
            mix = jnp.concatenate([_pool_mixer(u_pool, pool_w[i], pool_scale[i]), o], axis=-1) @ even_w_out[i]
            ret_states.append(jnp.stack([sf, sb], axis=1).astype(x.dtype))
        else:
            j = l // 2
            proj = h @ odd_w_in[j]
            q, k, v, r = jnp.split(proj, [GLA_DK_TOTAL, 2 * GLA_DK_TOTAL, 2 * GLA_DK_TOTAL + GLA_DV_TOTAL], axis=-1)
            q = q.reshape(B, T, H_GLA, DK_GLA) * (DK_GLA ** -0.5)
            k = k.reshape(B, T, H_GLA, DK_GLA)
            v = v.reshape(B, T, H_GLA, DV_GLA)
            z = jnp.einsum('btd,xdr->xbtr', h, gla_gw1[j])
            z = jnp.einsum('xbtr,xrk->xbtk', z, gla_gw2[j]) + gla_gb[j][:, None, None, :]
            loga = (jax.nn.log_sigmoid(z.astype(jnp.float32)) / GLA_TAU).reshape(2, B, T, H_GLA, DK_GLA)
            o, sf, sb = _bidir_scan(q, k, v, loga[0], loga[1], s_gla[:, j, 0], s_gla[:, j, 1])
            o = _head_rms(o, gla_norm_g[j]) * jax.nn.silu(r)
            mix = o @ odd_w_out[j]
            gla_states.append(jnp.stack([sf, sb], axis=1).astype(x.dtype))
        x = x + g1 * mix
        h = _rms_norm(x, norm2_g[l]) * (1 + sc2) + sh2
        a, b = jnp.split(h @ ffn_w_up[l], 2, axis=-1)
        a = _dwconv3(a, ffn_conv_w[l], ffn_conv_b[l])
        x = x + g2 * ((jax.nn.silu(a) * b) @ ffn_w_down[l])
    return _rms_norm(x, final_g), jnp.stack(ret_states, axis=1), jnp.stack(gla_states, axis=1)


def setup_inputs(seed: int = 0) -> dict:
    key = jax.random.key(seed)
    ks = jax.random.split(key, 32)
    nrm = lambda k, shape, s: jax.random.normal(k, shape, jnp.float32) * s
    D = D_MODEL
    gam = 1.0 - 2.0 ** (-5.0 - np.arange(H_RET))
    dec_logit = jnp.asarray(np.log(gam / (1.0 - gam)).astype(np.float32))
    return {
        "x_prompt": nrm(ks[0], (BATCH, SEQ, D), 1.0),
        "x_sample": nrm(ks[1], (DEC_BATCH, DEC_SEQ, D), 1.0),
        "state_ret": nrm(ks[2], (DEC_BATCH, N_EVEN, 2, H_RET, DK_RET, DV_RET), 0.5),
        "state_gla": nrm(ks[3], (DEC_BATCH, N_ODD, 2, H_GLA, DK_GLA, DV_GLA), 0.5),
        "c": nrm(ks[4], (DEC_BATCH, D), 1.0),
        "c_ctx": nrm(ks[5], (D,), 1.0),
        "ada_w": nrm(ks[6], (DEPTH, D, 6 * D), 0.5 * D ** -0.5),
        "ada_b": nrm(ks[7], (DEPTH, 6 * D), 0.01),
        "norm1_g": 1.0 + nrm(ks[8], (DEPTH, D), 0.02),
        "norm2_g": 1.0 + nrm(ks[9], (DEPTH, D), 0.02),
        "even_w_in": nrm(ks[10], (N_EVEN, D, EVEN_IN), D ** -0.5),
        "pool_w": nrm(ks[11], (N_EVEN, POOL_GROUPS, POOL_GC, POOL_GC), POOL_GC ** -0.5),
        "pool_scale": 1.0 + nrm(ks[12], (N_EVEN, POOL_WIDTH), 0.02),
        "ret_decay": dec_logit[None, None, :] + nrm(ks[13], (N_EVEN, 2, H_RET), 0.1),
        "ret_norm_g": 1.0 + nrm(ks[14], (N_EVEN, RET_WIDTH), 0.02),
        "even_w_out": nrm(ks[15], (N_EVEN, POOL_WIDTH + RET_WIDTH, D), (POOL_WIDTH + RET_WIDTH) ** -0.5),
        "odd_w_in": nrm(ks[16], (N_ODD, D, ODD_IN), D ** -0.5),
        "gla_gw1": nrm(ks[17], (N_ODD, 2, D, GLA_GATE_RANK), D ** -0.5),
        "gla_gw2": nrm(ks[18], (N_ODD, 2, GLA_GATE_RANK, GLA_DK_TOTAL), GLA_GATE_RANK ** -0.5),
        "gla_gb": nrm(ks[19], (N_ODD, 2, GLA_DK_TOTAL), 0.01),
        "gla_norm_g": 1.0 + nrm(ks[20], (N_ODD, GLA_DV_TOTAL), 0.02),
        "odd_w_out": nrm(ks[21], (N_ODD, GLA_DV_TOTAL, D), GLA_DV_TOTAL ** -0.5),
        "ffn_w_up": nrm(ks[22], (DEPTH, D, 2 * D_FF), D ** -0.5),
        "ffn_conv_w": nrm(ks[23], (DEPTH, CONV_W, D_FF), CONV_W ** -0.5),
        "ffn_conv_b": nrm(ks[24], (DEPTH, D_FF), 0.01),
        "ffn_w_down": nrm(ks[25], (DEPTH, D_FF, D), D_FF ** -0.5),
        "final_g": 1.0 + nrm(ks[26], (D,), 0.02),
    }


def reference(x_prompt, x_sample, state_ret, state_gla, c, c_ctx, ada_w, ada_b, norm1_g, norm2_g,
              even_w_in, pool_w, pool_scale, ret_decay, ret_norm_g, even_w_out, odd_w_in, gla_gw1,
              gla_gw2, gla_gb, gla_norm_g, odd_w_out, ffn_w_up, ffn_conv_w, ffn_conv_b, ffn_w_down, final_g):
    weights = (ada_w, ada_b, norm1_g, norm2_g, even_w_in, pool_w, pool_scale, ret_decay, ret_norm_g,
               even_w_out, odd_w_in, gla_gw1, gla_gw2, gla_gb, gla_norm_g, odd_w_out, ffn_w_up,
               ffn_conv_w, ffn_conv_b, ffn_w_down, final_g)
    Bp = x_prompt.shape[0]
    z_ret = jnp.zeros((Bp, N_EVEN, 2, H_RET, DK_RET, DV_RET), x_prompt.dtype)
    z_gla = jnp.zeros((Bp, N_ODD, 2, H_GLA, DK_GLA, DV_GLA), x_prompt.dtype)
    y_prompt, new_state_ret, new_state_gla = _trunk(x_prompt, c_ctx[None, :], z_ret, z_gla, None, *weights)
    rope = _rope_tables(x_sample.shape[1])
    y_sample, _, _ = _trunk(x_sample, c, state_ret, state_gla, rope, *weights)
    return (y_prompt, y_sample, new_state_ret, new_state_gla)
```

```cpp
#include <hip/hip_runtime.h>
#include <cstdio>
#include <cstdint>

#ifndef PROBE_DUP
#define PROBE_DUP 0
#endif
#define REP(k) for (int rep_ = 0; rep_ < ((PROBE_DUP) == (k) ? 2 : 1); ++rep_)
#ifndef CONV_IN_PROLOGUE
#define CONV_IN_PROLOGUE 0
#endif
#ifndef PROBE_LAUNCH_DUP
#define PROBE_LAUNCH_DUP 0
#endif
#ifndef MK_ONE_LAUNCH
#define MK_ONE_LAUNCH 1
#endif

namespace pg8 {
#define PG8_LAS __attribute__((address_space(3)))
typedef unsigned short bf16_t;
typedef short bf16x8 __attribute__((ext_vector_type(8)));
typedef float f32x4 __attribute__((ext_vector_type(4)));
typedef unsigned u32x4 __attribute__((ext_vector_type(4)));
constexpr int BM = 256, BK = 64, HALF = 128, HTB = HALF * BK * 2, STAGE_BYTES = 8 * HTB, NXCD = 8, WGM = 8;

__host__ __device__ __forceinline__ int lds_byte(int r, int c) { const int st = (r >> 4) * 2 + (c >> 5), rr = r & 15, cc = c & 31, ob = rr * 64 + cc * 2; return st * 1024 + (ob ^ (((ob >> 9) & 1) << 5)); }
__host__ __device__ __forceinline__ void stage_rc(int b, int& R, int& C) { const int st = b / 1024, sb = b % 1024, swz = sb ^ (((sb >> 9) & 1) << 5); R = (st >> 1) * 16 + swz / 64; C = (st & 1) * 32 + (swz % 64) / 2; }
__host__ __device__ __forceinline__ int perm32(int rho) { const int n = rho >> 4, i = rho & 15; return 8 * (i >> 2) + 4 * n + (i & 3); }

struct Unit { int pm, pn, k0, nt, sid; };
struct Gemm { const bf16_t* A; const bf16_t* Bt; int M, N, K, lda, ldb, a_pn_bytes; };

struct StaticOrder {
    int nM, nN, nwg, G, c;
    __host__ __device__ void init(int M, int N, int G_, int c_) { nM = M / BM; nN = N / BM; nwg = nM * nN; G = G_; c = c_; }
    __host__ __device__ void map(int L, Unit& u) const {
        int wgid = L; { const int q = nwg / NXCD, r = nwg % NXCD, xcd = wgid % NXCD, off = wgid / NXCD; wgid = (xcd < r ? xcd * (q + 1) : r * (q + 1) + (xcd - r) * q) + off; }
        const int nig = WGM * nN, gid = wgid / nig, fm = gid * WGM, gsz = (nM - fm) < WGM ? (nM - fm) : WGM;
        u.pm = fm + ((wgid % nig) % gsz); u.pn = (wgid % nig) / gsz; u.k0 = 0; u.nt = 0; u.sid = 0;
    }
    __host__ __device__ bool next(int i, Unit& u) const {
        const long L = (long)i * G + c; if (L >= nwg) return false;
        map((int)L, u); return true;
    }
    __device__ __forceinline__ void a_ready(const Unit&) const {}
    __device__ __forceinline__ void done(const Unit&) const {}
    __device__ __forceinline__ int arow(int pm) const { return pm * BM; }
};
struct UpOrder : StaticOrder {
    __device__ __forceinline__ int arow(int pm) const { return pm < 16 ? pm * BM : 4096 + ((pm - 16) / 17) * 4096 + 254 * ((pm - 16) % 17) - 1; }
};
struct SplitOrder : StaticOrder {
    int Kh;
    __device__ bool next(int i, Unit& u) const {
        if (G != 256 || nwg != 384) { const long L = (long)i * G + c; if (L >= nwg) return false; map((int)L, u); return true; }
        if (i == 0) { map(c, u); return true; }
        if (i == 1) { map(G + (c >> 1), u); u.k0 = (c & 1) * Kh; u.nt = Kh / BK; u.sid = c >> 1; return true; }
        return false;
    }
};
struct SingleOrder {
    int unit, nN;
    __device__ bool next(int i, Unit& u) const { if (i != 0 || unit < 0) return false; u.pm = unit / nN; u.pn = unit % nN; u.k0 = 0; u.nt = 0; u.sid = 0; return true; }
    __device__ __forceinline__ void a_ready(const Unit&) const {}
    __device__ __forceinline__ void done(const Unit&) const {}
    __device__ __forceinline__ int arow(int pm) const { return pm * BM; }
};

__device__ __forceinline__ unsigned cvt_pk_bf16(float lo, float hi) { unsigned r; asm volatile("v_cvt_pk_bf16_f32 %0, %1, %2" : "=v"(r) : "v"(lo), "v"(hi)); return r; }

struct EpiBf16 {
    static constexpr bool PERM = true;
    bf16_t* O; int ldc; float* Z; int zpn;
    __device__ __forceinline__ void operator()(f32x4 (&acc)[2][2][4][2], const Unit& u, int wr, int wc, int fr, int fq) const {
        const int row0 = u.pm * BM + wr * 64 + fr;
        if (u.pn == zpn) {
            if (wc == 0) {
#pragma unroll
                for (int ai = 0; ai < 2; ++ai)
#pragma unroll
                    for (int m = 0; m < 4; ++m) { float* zp = Z + (size_t)(row0 + ai * HALF + m * 16) * 32 + 8 * fq; *(f32x4*)zp = acc[ai][0][m][0]; *(f32x4*)(zp + 4) = acc[ai][0][m][1]; }
            }
            return;
        }
        const int col0 = u.pn * BM + wc * 32 + 8 * fq;
#pragma unroll
        for (int ai = 0; ai < 2; ++ai)
#pragma unroll
            for (int m = 0; m < 4; ++m) { bf16_t* rowp = O + (size_t)(row0 + ai * HALF + m * 16) * ldc + col0;
#pragma unroll
                for (int bj = 0; bj < 2; ++bj) { const f32x4 v0 = acc[ai][bj][m][0], v1 = acc[ai][bj][m][1];
                    u32x4 w; w.x = cvt_pk_bf16(v0[0], v0[1]); w.y = cvt_pk_bf16(v0[2], v0[3]); w.z = cvt_pk_bf16(v1[0], v1[1]); w.w = cvt_pk_bf16(v1[2], v1[3]);
                    *(u32x4*)(rowp + bj * HALF) = w; } }
    }
};
constexpr int SPLIT_CW = 16384;
constexpr size_t SPLIT_SLAB = (size_t)1119 << 20;
struct EpiResid {
    static constexpr bool PERM = true;
    const float* base_ctx; const float* base_smp; bool base_f32; bf16_t* out; const float* gate;
    unsigned char* wsb; PG8_LAS unsigned* ldsw; int spid; int cspid;
    __device__ __forceinline__ void operator()(f32x4 (&acc)[2][2][4][2], const Unit& u, int wr, int wc, int fr_in, int fq_in) const {
        int fr = fr_in, fq = fq_in; asm volatile("" : "+v"(fr), "+v"(fq));
        if (u.nt != 0) {
            const int wid = wr * 4 + wc, lane = fq * 16 + fr;
            unsigned* cnt = (unsigned*)wsb + SPLIT_CW + (cspid * 128 + u.sid) * 64; unsigned* flag = cnt + 32; unsigned* tmo = (unsigned*)wsb + 8;
            float* slab = (float*)(wsb + SPLIT_SLAB) + (size_t)spid * 128 * 65536;
            if (wid == 0 && lane == 0) *ldsw = __hip_atomic_fetch_add(cnt, 1u, __ATOMIC_RELAXED, __HIP_MEMORY_SCOPE_AGENT);
            asm volatile("s_waitcnt lgkmcnt(0)" ::: "memory"); __builtin_amdgcn_s_barrier(); asm volatile("" ::: "memory");
            const unsigned tk = *ldsw;
            const unsigned soff = (unsigned)u.sid * 262144u + (unsigned)wid * 16384u + (unsigned)lane * 16u;
            if (tk == 0u) {
                const __amdgpu_buffer_rsrc_t rs = __builtin_amdgcn_make_buffer_rsrc((void*)slab, (short)0, 128 * 262144, 0x00020000);
#pragma unroll
                for (int ai = 0; ai < 2; ++ai)
#pragma unroll
                    for (int bj = 0; bj < 2; ++bj)
#pragma unroll
                        for (int m = 0; m < 4; ++m) { const f32x4 v0 = acc[ai][bj][m][0], v1 = acc[ai][bj][m][1];
                            u32x4 w; w.x = cvt_pk_bf16(v0[0], v0[1]); w.y = cvt_pk_bf16(v0[2], v0[3]); w.z = cvt_pk_bf16(v1[0], v1[1]); w.w = cvt_pk_bf16(v1[2], v1[3]);
                            __builtin_amdgcn_raw_buffer_store_b128(w, rs, (int)soff, ((ai * 2 + bj) * 4 + m) * 1024, 16); }
                asm volatile("s_waitcnt vmcnt(0)" ::: "memory");
                if (lane == 0) __hip_atomic_fetch_add(flag, 1u, __ATOMIC_RELAXED, __HIP_MEMORY_SCOPE_AGENT);
                return;
            }
            if (wid == 0) {
                unsigned sp = 0;
                while ((unsigned)__builtin_amdgcn_readfirstlane(__hip_atomic_load(flag, __ATOMIC_RELAXED, __HIP_MEMORY_SCOPE_AGENT)) < 8u) {
                    __builtin_amdgcn_s_sleep(2);
                    if (++sp > (1u << 22)) { if (lane == 0) __hip_atomic_store(tmo, 1u, __ATOMIC_RELAXED, __HIP_MEMORY_SCOPE_AGENT); break; } }
                __builtin_amdgcn_fence(__ATOMIC_ACQUIRE, "agent");
                asm volatile("s_waitcnt vmcnt(0)" ::: "memory");
            }
            asm volatile("" ::: "memory"); __builtin_amdgcn_s_barrier(); asm volatile("" ::: "memory");
            const __amdgpu_buffer_rsrc_t rs = __builtin_amdgcn_make_buffer_rsrc((void*)slab, (short)0, 128 * 262144, 0x00020000);
            finish<true>(acc, u, wr, wc, fr, fq, rs, (int)soff);
            return;
        }
        const __amdgpu_buffer_rsrc_t rs0 = __builtin_amdgcn_make_buffer_rsrc((void*)wsb, (short)0, 16, 0x00020000);
        finish<false>(acc, u, wr, wc, fr, fq, rs0, 0);
    }
    template <bool ADD>
    __device__ __forceinline__ void finish(const f32x4 (&acc)[2][2][4][2], const Unit& u, int wr, int wc, int fr, int fq, const __amdgpu_buffer_rsrc_t rs, int soff) const {
        if (base_f32) finish2<ADD, true>(acc, u, wr, wc, fr, fq, rs, soff); else finish2<ADD, false>(acc, u, wr, wc, fr, fq, rs, soff);
    }
    template <bool ADD, bool F32B>
    __device__ __forceinline__ void finish2(const f32x4 (&acc)[2][2][4][2], const Unit& u, int wr, int wc, int fr, int fq, const __amdgpu_buffer_rsrc_t rs, int soff) const {
        constexpr int MB = F32B ? 2 : 4;
        const int cv = u.pm < 16 ? 0 : 1 + ((u.pm - 16) >> 4);
        const float* bp = u.pm < 16 ? base_ctx + (size_t)u.pm * BM * 2048 : base_smp + (size_t)(u.pm - 16) * BM * 2048;
        const bf16_t* xb = out + (size_t)u.pm * BM * 2048; bf16_t* op = out + (size_t)u.pm * BM * 2048;
        const int col0 = u.pn * BM + wc * 32 + 8 * fq;
        const float* gp = gate + (size_t)cv * 12288 + col0;
        f32x4 gv[2][2];
#pragma unroll
        for (int bj = 0; bj < 2; ++bj)
#pragma unroll
            for (int n = 0; n < 2; ++n) gv[bj][n] = *(const f32x4*)(gp + bj * HALF + 4 * n);
#pragma unroll
        for (int ai = 0; ai < 2; ++ai)
#pragma unroll
            for (int m0 = 0; m0 < 4; m0 += MB) {
                f32x4 fb[MB][2][2]; u32x4 xw[MB][2]; u32x4 sw[MB][2];
#pragma unroll
                for (int mm = 0; mm < MB; ++mm) { const unsigned off = (unsigned)((ai * HALF + wr * 64 + (m0 + mm) * 16 + fr) * 2048 + col0);
#pragma unroll
                    for (int bj = 0; bj < 2; ++bj) {
                        if (F32B) { fb[mm][bj][0] = *(const f32x4*)(bp + off + bj * HALF); fb[mm][bj][1] = *(const f32x4*)(bp + off + bj * HALF + 4); }
                        else xw[mm][bj] = *(const u32x4*)(xb + off + bj * HALF);
                        if (ADD) sw[mm][bj] = __builtin_amdgcn_raw_buffer_load_b128(rs, soff, ((ai * 2 + bj) * 4 + m0 + mm) * 1024, 0); } }
                __builtin_amdgcn_sched_barrier(0);
#pragma unroll
                for (int mm = 0; mm < MB; ++mm) { const int m = m0 + mm; const unsigned off = (unsigned)((ai * HALF + wr * 64 + m * 16 + fr) * 2048 + col0);
#pragma unroll
                    for (int bj = 0; bj < 2; ++bj) { f32x4 b0, b1;
                        if (F32B) { b0 = fb[mm][bj][0]; b1 = fb[mm][bj][1]; }
                        else { const u32x4 w = xw[mm][bj];
                            b0 = (f32x4){__builtin_bit_cast(float, w.x << 16), __builtin_bit_cast(float, w.x & 0xffff0000u), __builtin_bit_cast(float, w.y << 16), __builtin_bit_cast(float, w.y & 0xffff0000u)};
                            b1 = (f32x4){__builtin_bit_cast(float, w.z << 16), __builtin_bit_cast(float, w.z & 0xffff0000u), __builtin_bit_cast(float, w.w << 16), __builtin_bit_cast(float, w.w & 0xffff0000u)}; }
                        f32x4 v0 = acc[ai][bj][m][0], v1 = acc[ai][bj][m][1];
                        if (ADD) { const u32x4 w = sw[mm][bj];
                            { const unsigned o0 = cvt_pk_bf16(v0[0], v0[1]), o1 = cvt_pk_bf16(v0[2], v0[3]), o2 = cvt_pk_bf16(v1[0], v1[1]), o3 = cvt_pk_bf16(v1[2], v1[3]);
                              v0 = (f32x4){__builtin_bit_cast(float, o0 << 16), __builtin_bit_cast(float, o0 & 0xffff0000u), __builtin_bit_cast(float, o1 << 16), __builtin_bit_cast(float, o1 & 0xffff0000u)};
                              v1 = (f32x4){__builtin_bit_cast(float, o2 << 16), __builtin_bit_cast(float, o2 & 0xffff0000u), __builtin_bit_cast(float, o3 << 16), __builtin_bit_cast(float, o3 & 0xffff0000u)}; }
                            v0 += (f32x4){__builtin_bit_cast(float, w.x << 16), __builtin_bit_cast(float, w.x & 0xffff0000u), __builtin_bit_cast(float, w.y << 16), __builtin_bit_cast(float, w.y & 0xffff0000u)};
                            v1 += (f32x4){__builtin_bit_cast(float, w.z << 16), __builtin_bit_cast(float, w.z & 0xffff0000u), __builtin_bit_cast(float, w.w << 16), __builtin_bit_cast(float, w.w & 0xffff0000u)}; }
                        const f32x4 x0 = b0 + gv[bj][0] * v0, x1 = b1 + gv[bj][1] * v1;
                        u32x4 w; w.x = cvt_pk_bf16(x0[0], x0[1]); w.y = cvt_pk_bf16(x0[2], x0[3]); w.z = cvt_pk_bf16(x1[0], x1[1]); w.w = cvt_pk_bf16(x1[2], x1[3]);
                        *(u32x4*)(op + off + bj * HALF) = w; } }
                asm volatile("" ::: "memory"); __builtin_amdgcn_sched_barrier(0); }
    }
};
__device__ __forceinline__ float dpp_ror1(float v) { return __builtin_bit_cast(float, __builtin_amdgcn_update_dpp(0, __builtin_bit_cast(int, v), 0x121, 0xF, 0xF, true)); }
__device__ __forceinline__ float dpp_rol1(float v) { return __builtin_bit_cast(float, __builtin_amdgcn_update_dpp(0, __builtin_bit_cast(int, v), 0x12F, 0xF, 0xF, true)); }
__device__ __forceinline__ float dpp_shr1(float edge, float v) { return __builtin_bit_cast(float, __builtin_amdgcn_update_dpp(__builtin_bit_cast(int, edge), __builtin_bit_cast(int, v), 0x111, 0xF, 0xF, false)); }
__device__ __forceinline__ float dpp_shl1(float edge, float v) { return __builtin_bit_cast(float, __builtin_amdgcn_update_dpp(__builtin_bit_cast(int, edge), __builtin_bit_cast(int, v), 0x101, 0xF, 0xF, false)); }
__device__ __forceinline__ f32x4 shr1v(const f32x4 e, const f32x4 v) { return (f32x4){dpp_shr1(e[0], v[0]), dpp_shr1(e[1], v[1]), dpp_shr1(e[2], v[2]), dpp_shr1(e[3], v[3])}; }
__device__ __forceinline__ f32x4 shl1v(const f32x4 e, const f32x4 v) { return (f32x4){dpp_shl1(e[0], v[0]), dpp_shl1(e[1], v[1]), dpp_shl1(e[2], v[2]), dpp_shl1(e[3], v[3])}; }
__device__ __forceinline__ f32x4 ror1v(const f32x4 v) { return (f32x4){dpp_ror1(v[0]), dpp_ror1(v[1]), dpp_ror1(v[2]), dpp_ror1(v[3])}; }
__device__ __forceinline__ f32x4 rol1v(const f32x4 v) { return (f32x4){dpp_rol1(v[0]), dpp_rol1(v[1]), dpp_rol1(v[2]), dpp_rol1(v[3])}; }
struct EpiUpConv {
    static constexpr bool PERM = true;
    bf16_t* ACT; const float* cw; const float* cb; PG8_LAS float* xb;
    __device__ __forceinline__ void operator()(f32x4 (&acc)[2][2][4][2], const Unit& u, int wr, int wc, int fr, int fq) const {
        constexpr int FFc = 5632;
        const bool ctx = u.pm < 16;
        const int pk = ctx ? 0 : (u.pm - 16) % 17, ps = ctx ? 0 : (u.pm - 16) / 17;
        const int T = ctx ? 256 : 4096, pos0 = ctx ? 0 : 254 * pk - 1;
        const int grow0 = ctx ? u.pm * BM : 4096 + ps * 4096 + pos0;
        const int ch = u.pn * 128 + wc * 32 + 8 * fq;
        f32x4 w0[2], w1[2], w2[2], bb[2];
#pragma unroll
        for (int n = 0; n < 2; ++n) { w0[n] = *(const f32x4*)(cw + ch + 4 * n); w1[n] = *(const f32x4*)(cw + FFc + ch + 4 * n); w2[n] = *(const f32x4*)(cw + 2 * FFc + ch + 4 * n); bb[n] = *(const f32x4*)(cb + ch + 4 * n); }
#pragma unroll
        for (int ai = 0; ai < 2; ++ai)
#pragma unroll
            for (int m = 0; m < 4; ++m) { const int pos = pos0 + ai * HALF + wr * 64 + m * 16 + fr; if ((unsigned)pos >= (unsigned)T) { acc[ai][0][m][0] = (f32x4){0.f, 0.f, 0.f, 0.f}; acc[ai][0][m][1] = (f32x4){0.f, 0.f, 0.f, 0.f}; } }
#pragma unroll
        for (int ai = 0; ai < 2; ++ai) { PG8_LAS float* xp = xb + ((wc * 4 + 2 * ai + wr) * 2) * 32 + 8 * fq;
            if (fr == 0) { *(PG8_LAS f32x4*)xp = acc[ai][0][0][0]; *(PG8_LAS f32x4*)(xp + 4) = acc[ai][0][0][1]; }
            if (fr == 15) { *(PG8_LAS f32x4*)(xp + 32) = acc[ai][0][3][0]; *(PG8_LAS f32x4*)(xp + 36) = acc[ai][0][3][1]; } }
        asm volatile("s_waitcnt lgkmcnt(0)" ::: "memory"); __builtin_amdgcn_s_barrier(); asm volatile("" ::: "memory");
#pragma unroll
        for (int ai = 0; ai < 2; ++ai) {
            const int bI = 2 * ai + wr;
            f32x4 pe[2], ne[2];
#pragma unroll
            for (int n = 0; n < 2; ++n) {
                pe[n] = bI > 0 ? *(const PG8_LAS f32x4*)(xb + ((wc * 4 + bI - 1) * 2 + 1) * 32 + 8 * fq + 4 * n) : (f32x4){0.f, 0.f, 0.f, 0.f};
                ne[n] = bI < 3 ? *(const PG8_LAS f32x4*)(xb + ((wc * 4 + bI + 1) * 2 + 0) * 32 + 8 * fq + 4 * n) : (f32x4){0.f, 0.f, 0.f, 0.f}; }
#pragma unroll
            for (int m = 0; m < 4; ++m) {
                const int tr = ai * HALF + wr * 64 + m * 16 + fr;
                u32x4 w;
#pragma unroll
                for (int n = 0; n < 2; ++n) {
                    const f32x4 cur = acc[ai][0][m][n];
                    const f32x4 rp = m > 0 ? ror1v(acc[ai][0][m > 0 ? m - 1 : 0][n]) : pe[n];
                    const f32x4 ln = m < 3 ? rol1v(acc[ai][0][m < 3 ? m + 1 : 3][n]) : ne[n];
                    const f32x4 prev = shr1v(rp, cur), next = shl1v(ln, cur);
                    const f32x4 av = __builtin_elementwise_fma(next, w2[n], __builtin_elementwise_fma(cur, w1[n], __builtin_elementwise_fma(prev, w0[n], bb[n])));
                    const f32x4 bv = acc[ai][1][m][n];
                    const f32x4 ab = av * bv, ex = av * -1.4426950408889634f;
                    f32x4 o;
#pragma unroll
                    for (int j = 0; j < 4; ++j) o[j] = ab[j] * __builtin_amdgcn_rcpf(1.0f + __builtin_amdgcn_exp2f(ex[j]));
                    if (n == 0) { w.x = cvt_pk_bf16(o[0], o[1]); w.y = cvt_pk_bf16(o[2], o[3]); } else { w.z = cvt_pk_bf16(o[0], o[1]); w.w = cvt_pk_bf16(o[2], o[3]); }
                }
                const bool st = ctx || (tr >= 1 && tr <= 254 && pos0 + tr < T);
                if (st) *(u32x4*)(ACT + (size_t)(grow0 + tr) * FFc + ch) = w;
            }
        }
    }
};

template <class Epi, class Sched, bool ALIGN_EPI>
__device__ __forceinline__ void gemm_phase(PG8_LAS unsigned char* lds, const Gemm g, const Sched& S, const Epi& E, const int tid) {
    const int wid = __builtin_amdgcn_readfirstlane(tid >> 6), lane = tid & 63, wr = wid >> 2, wc = wid & 3, fr = lane & 15, fq = lane >> 4;
    const int K = g.K, nt = K / BK;
    unsigned voffA[2], voffB[2];
#pragma unroll
    for (int i = 0; i < 2; ++i) { int R, C; stage_rc(tid * 16 + i * 8192, R, C); const int Rb = Epi::PERM ? ((R & ~31) + perm32(R & 31)) : R;
        voffA[i] = (unsigned)(R * g.lda + C) * 2u; voffB[i] = (unsigned)(Rb * g.ldb + C) * 2u; }
    const size_t kstep = (size_t)(BK * 2);
    const size_t hstepA = (size_t)HALF * g.lda * 2, hstepB = (size_t)HALF * g.ldb * 2;
    const size_t tstepB = 2 * hstepB;
    const unsigned ldsw = (unsigned)wid * 1024u;
    const int aoff = lds_byte(wr * 64 + fr, fq * 8), boff = lds_byte(wc * 32 + fr, fq * 8);
#define PG8_SA(b, h) (((b) * 2 + (h)) * HTB)
#define PG8_SB(b, h) ((4 + (b) * 2 + (h)) * HTB)
#define PG8_STAGE(bufoff, gbase, voff) do { _Pragma("unroll") for (int _i = 0; _i < 2; ++_i) \
        __builtin_amdgcn_global_load_lds((const unsigned*)((const char*)(gbase) + (voff)[_i]), (PG8_LAS unsigned*)(lds + (bufoff) + ldsw + _i * 8192), 16, 0, 0); } while (0)
#define PG8_LDA(dst, b, h) do { _Pragma("unroll") for (int m = 0; m < 4; ++m) _Pragma("unroll") for (int k = 0; k < 2; ++k) dst[m][k] = *(const PG8_LAS bf16x8*)(lds + PG8_SA(b, h) + aoff + m * 2048 + k * 1024); } while (0)
#define PG8_LDB(dst, b, h) do { _Pragma("unroll") for (int n = 0; n < 2; ++n) _Pragma("unroll") for (int k = 0; k < 2; ++k) dst[n][k] = *(const PG8_LAS bf16x8*)(lds + PG8_SB(b, h) + boff + n * 2048 + k * 1024); } while (0)
#define PG8_MMA(ai, bj, At, Bt) do { __builtin_amdgcn_s_setprio(1); _Pragma("unroll") for (int m = 0; m < 4; ++m) _Pragma("unroll") for (int n = 0; n < 2; ++n) _Pragma("unroll") for (int k = 0; k < 2; ++k) \
        acc[ai][bj][m][n] = __builtin_amdgcn_mfma_f32_16x16x32_bf16(Bt[n][k], At[m][k], acc[ai][bj][m][n], 0, 0, 0); __builtin_amdgcn_s_setprio(0); } while (0)
#define PG8_WAIT_V(n) asm volatile("s_waitcnt vmcnt(" #n ")" ::: "memory")
#define PG8_WAIT_L(n) asm volatile("s_waitcnt lgkmcnt(" #n ")" ::: "memory")
#define PG8_BAR __builtin_amdgcn_s_barrier()
#define PG8_SCHED __builtin_amdgcn_sched_barrier(0)
    Unit cur, nxt; int ui = 0;
    if (!S.next(0, cur)) return;
    f32x4 acc[2][2][4][2];
#pragma unroll
    for (int a = 0; a < 2; ++a)
#pragma unroll
        for (int b = 0; b < 2; ++b)
#pragma unroll
            for (int m = 0; m < 4; ++m)
#pragma unroll
                for (int n = 0; n < 2; ++n) acc[a][b][m][n] = (f32x4){0.f, 0.f, 0.f, 0.f};
    bf16x8 At[4][2], B0[2][2], B1[2][2];
    const size_t rowA = (size_t)g.lda * 2;
    const char* cA = (const char*)g.A + (size_t)S.arow(cur.pm) * rowA + (size_t)cur.pn * g.a_pn_bytes + (size_t)cur.k0 * 2; const char* cB = (const char*)g.Bt + (size_t)cur.pn * tstepB + (size_t)cur.k0 * 2;
    int ntc = cur.nt ? cur.nt : nt;
    S.a_ready(cur);
    PG8_STAGE(PG8_SB(0, 0), cB, voffB); PG8_STAGE(PG8_SB(0, 1), cB + hstepB, voffB); PG8_STAGE(PG8_SA(0, 0), cA, voffA); PG8_STAGE(PG8_SA(0, 1), cA + hstepA, voffA);
    if (wr == 1) PG8_BAR;
    PG8_WAIT_V(2); PG8_BAR;
    PG8_STAGE(PG8_SB(1, 0), cB + kstep, voffB); PG8_STAGE(PG8_SA(1, 0), cA + kstep, voffA); PG8_STAGE(PG8_SB(1, 1), cB + hstepB + kstep, voffB);
    PG8_WAIT_V(6); PG8_BAR;
    for (;;) {
        const bool has_next = S.next(ui + 1, nxt);
        const char* nA = has_next ? (const char*)g.A + (size_t)S.arow(nxt.pm) * rowA + (size_t)nxt.pn * g.a_pn_bytes + (size_t)nxt.k0 * 2 : cA; const char* nB = has_next ? (const char*)g.Bt + (size_t)nxt.pn * tstepB + (size_t)nxt.k0 * 2 : cB;
        for (int t = 0; t < ntc; t += 2) {
            const bool last = (t == ntc - 2);
            const char* a1 = cA + (size_t)(t + 1) * kstep;
            const char* a2 = last ? nA : cA + (size_t)(t + 2) * kstep; const char* b2 = last ? nB : cB + (size_t)(t + 2) * kstep;
            const char* a3 = a2 + kstep; const char* b3 = b2 + kstep;
            if (last && has_next) S.a_ready(nxt);
            PG8_LDB(B0, 0, 0); PG8_LDB(B1, 0, 1); PG8_SCHED; PG8_LDA(At, 0, 0); PG8_STAGE(PG8_SA(1, 1), a1 + hstepA, voffA);
            PG8_WAIT_V(8); PG8_WAIT_L(0); PG8_BAR; PG8_MMA(0, 0, At, B0); PG8_MMA(0, 1, At, B1); PG8_BAR; PG8_SCHED;
            PG8_LDA(At, 0, 1); PG8_STAGE(PG8_SB(0, 0), b2, voffB); PG8_STAGE(PG8_SB(0, 1), b2 + hstepB, voffB); PG8_STAGE(PG8_SA(0, 0), a2, voffA);
            PG8_WAIT_V(8); PG8_WAIT_L(0); PG8_BAR; PG8_MMA(1, 0, At, B0); PG8_MMA(1, 1, At, B1); PG8_BAR; PG8_SCHED;
            PG8_LDB(B0, 1, 0); PG8_LDB(B1, 1, 1); PG8_SCHED; PG8_LDA(At, 1, 0); PG8_STAGE(PG8_SA(0, 1), a2 + hstepA, voffA);
            PG8_WAIT_V(8); PG8_WAIT_L(0); PG8_BAR; PG8_MMA(0, 0, At, B0); PG8_MMA(0, 1, At, B1); PG8_BAR; PG8_SCHED;
            PG8_LDA(At, 1, 1); PG8_STAGE(PG8_SB(1, 0), b3, voffB); PG8_STAGE(PG8_SB(1, 1), b3 + hstepB, voffB); PG8_STAGE(PG8_SA(1, 0), a3, voffA);
            PG8_WAIT_V(8); PG8_WAIT_L(0); PG8_BAR; PG8_MMA(1, 0, At, B0); PG8_MMA(1, 1, At, B1); PG8_BAR; PG8_SCHED;
        }
        if constexpr (ALIGN_EPI) { if (wr == 0) PG8_BAR; }
        E(acc, cur, wr, wc, fr, fq); S.done(cur);
        if (!has_next) break;
#pragma unroll
        for (int a = 0; a < 2; ++a)
#pragma unroll
            for (int b = 0; b < 2; ++b)
#pragma unroll
                for (int m = 0; m < 4; ++m)
#pragma unroll
                    for (int n = 0; n < 2; ++n) acc[a][b][m][n] = (f32x4){0.f, 0.f, 0.f, 0.f};
        cur = nxt; cA = nA; cB = nB; ++ui; ntc = cur.nt ? cur.nt : nt;
        if constexpr (ALIGN_EPI) { if (wr == 1) PG8_BAR; }
    }
    PG8_WAIT_V(0);
    if constexpr (!ALIGN_EPI) { if (wr == 0) PG8_BAR; }
    PG8_BAR;
#undef PG8_SA
#undef PG8_SB
#undef PG8_STAGE
#undef PG8_LDA
#undef PG8_LDB
#undef PG8_MMA
#undef PG8_WAIT_V
#undef PG8_WAIT_L
#undef PG8_BAR
#undef PG8_SCHED
}
}

constexpr int NWAVES = 8;
constexpr int D = 2048, M = 12288, NCTX = 4096;
constexpr int FF = 5632, NUP = 11264;
constexpr int EVEN_IN = 5120, ODD_INP = 6400;
constexpr int NCHUNK = 192;
constexpr float EPS = 1e-6f;
constexpr size_t OUT_SR = (size_t)M * D;
constexpr size_t OUT_SG = OUT_SR + (size_t)16 * 2 * 2 * 8 * 128 * 128;

constexpr size_t MiB = 1u << 20;
constexpr size_t WS_CTL = 0, CTL_ZERO_BYTES = 1 * MiB;
constexpr size_t WS_MOD = 1 * MiB;
constexpr size_t WS_WEIN = 2 * MiB;
constexpr size_t WS_WOIN = WS_WEIN + 40 * MiB;
constexpr size_t WS_WEOUT = WS_WOIN + 50 * MiB;
constexpr size_t WS_WOOUT = WS_WEOUT + 16 * MiB;
constexpr size_t WS_WPOOL = WS_WOOUT + 16 * MiB;
constexpr size_t WS_WUP = WS_WPOOL + 1 * MiB;
constexpr size_t WS_WDN = WS_WUP + 176 * MiB;
constexpr size_t WS_X = WS_WDN + 88 * MiB;
constexpr size_t WS_H = WS_X + 96 * MiB;
constexpr size_t WS_T = WS_H + 48 * MiB;
constexpr size_t WS_PROJ = WS_T;
constexpr size_t WS_Z1 = WS_PROJ + 150 * MiB;
constexpr size_t WS_QD = WS_Z1 + 2 * MiB;
constexpr size_t WS_KTT = WS_QD + 48 * MiB;
constexpr size_t WS_AM = WS_KTT + 48 * MiB;
constexpr size_t WS_DEC = WS_AM + 24 * MiB;
constexpr size_t WS_VT = WS_DEC + 2 * MiB;
constexpr size_t WS_POOLED = WS_VT + 48 * MiB;
constexpr size_t WS_O = WS_POOLED + 24 * MiB;
constexpr size_t WS_CAT = WS_O + 192 * MiB;
constexpr size_t WS_T_END1 = WS_CAT + 48 * MiB;
constexpr size_t WS_UP = WS_T;
constexpr size_t WS_ACT = WS_UP + 264 * MiB;
constexpr size_t WS_T_END2 = WS_ACT + 132 * MiB;
constexpr size_t WS_END = WS_T_END1 > WS_T_END2 ? WS_T_END1 : WS_T_END2;
constexpr int CW_BAR = 4096;
constexpr int CW_SPLIT = 16384;
constexpr int CW_TMO = 8;
constexpr size_t WS_SLAB = WS_END;
constexpr size_t WS_END2 = WS_SLAB + 256 * MiB;
static_assert(WS_SLAB == pg8::SPLIT_SLAB && CW_SPLIT == pg8::SPLIT_CW && CW_TMO == 8, "split-unit constants");
static_assert((CW_SPLIT + 16 * 128 * 64) * 4 <= (int)CTL_ZERO_BYTES, "control words inside the per-call memset");

constexpr int LDS_BYTES = 147456;
constexpr int MISC_OFF = 146944;

#define GAS __attribute__((address_space(1)))
#define LAS __attribute__((address_space(3)))
typedef unsigned short bf16;
typedef float f32x4 __attribute__((ext_vector_type(4)));
typedef unsigned u32x4 __attribute__((ext_vector_type(4)));
typedef unsigned u32x2 __attribute__((ext_vector_type(2)));
typedef short bf16x8 __attribute__((ext_vector_type(8)));
typedef short bf16x4 __attribute__((ext_vector_type(4)));
#define LDS_WAIT() asm volatile("s_waitcnt lgkmcnt(0)" ::: "memory")
__device__ __forceinline__ unsigned pk2(float lo, float hi) { unsigned r; asm("v_cvt_pk_bf16_f32 %0, %1, %2" : "=v"(r) : "v"(lo), "v"(hi)); return r; }
__device__ __forceinline__ unsigned f2bf(float f) { return pk2(f, 0.f); }
__device__ __forceinline__ float bf2f(unsigned short b) { return __builtin_bit_cast(float, (unsigned)b << 16); }
__device__ __forceinline__ float bflo(unsigned w) { return __builtin_bit_cast(float, w << 16); }
__device__ __forceinline__ float bfhi(unsigned w) { return __builtin_bit_cast(float, w & 0xffff0000u); }
__device__ __forceinline__ float sigmoidf_(float x) { return 1.f / (1.f + __expf(-x)); }
__device__ __forceinline__ float logsigmoidf_(float x) { return fminf(x, 0.f) - log1pf(__expf(-fabsf(x))); }

#define XB_TMO      128
#define XB_XCNT(j)  (256  + 64 * (j))
#define XB_XSUB(j)  (1280 + 64 * (j))
#define XB_XGEN(j)  (2304 + 64 * (j))
#define XB_TOP      3328
#define XB_TOPGEN   3392
#define XCD_BAR_WORDS 3456
#define XB_SPIN_CAP (1u << 18)

__device__ __forceinline__ unsigned xb_ld(unsigned* p)              { return __hip_atomic_load(p, __ATOMIC_RELAXED, __HIP_MEMORY_SCOPE_AGENT); }
__device__ __forceinline__ unsigned xb_add(unsigned* p, unsigned v) { return __hip_atomic_fetch_add(p, v, __ATOMIC_RELAXED, __HIP_MEMORY_SCOPE_AGENT); }
__device__ __forceinline__ unsigned xb_xcc_id() { return (unsigned)__builtin_amdgcn_s_getreg((3 << 11) | 20) & 0xFu; }
#define XB_SPIN(cond, bar) do { unsigned _sp = 0; while (cond) { __builtin_amdgcn_s_sleep(1); \
    if ((++_sp & 255u) == 0u) { if (xb_ld(&(bar)[XB_TMO])) break; if (_sp > XB_SPIN_CAP) { atomicAdd(&(bar)[XB_TMO], 1u); break; } } } } while (0)

struct XcdBarrier { unsigned* bar; unsigned x; volatile LAS unsigned* st; };

__device__ __forceinline__ XcdBarrier xcd_barrier_post(unsigned* bar, volatile LAS unsigned* st) {
    XcdBarrier b; b.bar = bar; b.x = xb_xcc_id(); b.st = st;
    if (threadIdx.x == 0) (void)xb_add(&bar[XB_XCNT(b.x)], 1u);
    return b;
}
__device__ __forceinline__ void xcd_barrier_complete(unsigned* bar, unsigned x, unsigned& nloc, unsigned& nx) {
    const unsigned G = gridDim.x * gridDim.y * gridDim.z;
    unsigned sum, cnt, mine, sp = 0u;
    for (;;) {
        sum = 0u; cnt = 0u; mine = 0u;
#pragma unroll
        for (unsigned j = 0; j < 16; ++j) { const unsigned c = xb_ld(&bar[XB_XCNT(j)]); sum += c; cnt += (c > 0u) ? 1u : 0u; mine = (j == x) ? c : mine; }
        if (sum == G) break;
        __builtin_amdgcn_s_sleep(1);
        if ((++sp & 255u) == 0u) { if (xb_ld(&bar[XB_TMO])) break; if (sp > XB_SPIN_CAP) { atomicAdd(&bar[XB_TMO], 1u); break; } }
    }
    nloc = mine > 0u ? mine : 1u; nx = cnt > 0u ? cnt : 1u;
}
__device__ __forceinline__ void xcd_barrier(const XcdBarrier& b) {
    asm volatile("s_waitcnt vmcnt(0)" ::: "memory");
    __syncthreads();
    if (threadIdx.x == 0) {
        unsigned* bar = b.bar;
        __builtin_amdgcn_s_waitcnt(0);
        unsigned nloc = b.st[0], nx = b.st[1];
        if (nloc == 0u) { xcd_barrier_complete(bar, b.x, nloc, nx); b.st[0] = nloc; b.st[1] = nx; }
        const unsigned old = xb_add(&bar[XB_XSUB(b.x)], 1u);
        const unsigned gen = old / nloc;
        if (old + 1u == (gen + 1u) * nloc) {
            __builtin_amdgcn_fence(__ATOMIC_RELEASE, "agent");
            asm volatile("s_waitcnt vmcnt(0)" ::: "memory");
            const unsigned og = xb_add(&bar[XB_TOP], 1u);
            const unsigned tg = og / nx;
            if (og + 1u == (tg + 1u) * nx) xb_add(&bar[XB_TOPGEN], 1u);
            else XB_SPIN(xb_ld(&bar[XB_TOPGEN]) == tg, bar);
            __builtin_amdgcn_fence(__ATOMIC_ACQUIRE, "agent");
            xb_add(&bar[XB_XGEN(b.x)], 1u);
            asm volatile("s_waitcnt vmcnt(0)" ::: "memory");
        } else {
            XB_SPIN(xb_ld(&bar[XB_XGEN(b.x)]) == gen, bar);
            __builtin_amdgcn_fence(__ATOMIC_ACQUIRE, "agent");
            asm volatile("s_waitcnt vmcnt(0)" ::: "memory");
        }
    }
    __syncthreads();
}

enum { I_XP = 0, I_XS, I_SRET, I_SGLA, I_C, I_CCTX, I_ADAW, I_ADAB, I_N1G, I_N2G, I_EWIN, I_POOLW, I_POOLS, I_RDEC, I_RNG, I_EWOUT, I_OWIN, I_GW1, I_GW2, I_GB, I_GNG, I_OWOUT, I_WUP, I_CONVW, I_CONVB, I_WDN, I_FING, N_IN };
struct Args { const float* in[N_IN]; float* out; unsigned char* ws; int ph_lo, ph_hi, dry, pad; };

__device__ __forceinline__ float shfl_xor_l(float v, int o, int lane) { return __builtin_bit_cast(float, __builtin_amdgcn_ds_bpermute((lane ^ o) << 2, __builtin_bit_cast(int, v))); }
__device__ __forceinline__ float wave_sum(float v, int lane) {
#pragma unroll
    for (int o = 1; o < 64; o <<= 1) v += shfl_xor_l(v, o, lane);
    return v;
}

struct TrItem { const float* W; bf16* WT; const float* nscale; int ldw, ldk, k0, n0, dn0; };
__device__ __forceinline__ void tr_load(const TrItem& t, int lane, f32x4 (&wv)[8]) {
    const float* wp = t.W + (size_t)(t.k0 + (lane >> 3)) * t.ldw + t.n0 + 4 * (lane & 7);
#pragma unroll
    for (int i = 0; i < 8; ++i) wv[i] = *(const f32x4*)(wp + (size_t)(8 * i) * t.ldw);
}
__device__ __forceinline__ void tr_finish(const TrItem& t, const f32x4 (&wv)[8], LAS float* scr, int lane) {
#pragma unroll
    for (int i = 0; i < 8; ++i)
#pragma unroll
        for (int j = 0; j < 4; ++j) scr[(8 * i + (lane >> 3)) * 33 + 4 * (lane & 7) + j] = wv[i][j];
    LDS_WAIT(); asm volatile("" ::: "memory");
    const int c = lane & 7;
#pragma unroll
    for (int j = 0; j < 4; ++j) { const int n = (lane >> 3) + 8 * j; const LAS float* s = scr + (8 * c) * 33 + n; const float sc = t.nscale ? t.nscale[t.n0 + n] : 1.0f;
        u32x4 o; o.x = pk2(s[0 * 33] * sc, s[1 * 33] * sc); o.y = pk2(s[2 * 33] * sc, s[3 * 33] * sc); o.z = pk2(s[4 * 33] * sc, s[5 * 33] * sc); o.w = pk2(s[6 * 33] * sc, s[7 * 33] * sc);
        *(u32x4*)(t.WT + (size_t)(t.dn0 + n) * t.ldk + t.k0 + 8 * c) = o; }
    LDS_WAIT(); asm volatile("" ::: "memory");
}
__device__ __forceinline__ void convert_layer(const Args& a, unsigned char* ws, LAS float* scr, int l, int parts, int lo, int hi, bool extras, int widx, int nw, int lane, int tidx, int nthreads) {
    constexpr int C_EIN = 32 * 160, C_OIN = 32 * 192, C_OUT = 32 * 64, C_POOL = 4 * 8, C_UP = 32 * 352, C_DN = 88 * 64;
    const int li = l >> 1; const bool odd = (l & 1) != 0;
    const int c_in = (parts & 1) ? (odd ? C_OIN : C_EIN) : 0, c_out = (parts & 2) ? C_OUT : 0, c_pool = ((parts & 1) && !odd) ? 4 * C_POOL : 0, c_up = (parts & 2) ? C_UP : 0, c_dn = (parts & 2) ? C_DN : 0;
    const int ntot = c_in + c_out + c_pool + c_up + c_dn;
    const int nitems = (hi < ntot ? hi : ntot) - lo;
    auto tile_of = [&](int r, int NT, int& kt, int& nt) { constexpr int CBK = 1, CBN = 8 / CBK; const int blk = r >> 3, w = r & 7, nb = NT / CBN; kt = CBK * (blk / nb) + (w / CBN); nt = CBN * (blk % nb) + (w % CBN); };
    auto decode = [&](int r) -> TrItem {
        TrItem t; t.nscale = nullptr; r += lo; int kt, nt;
        if (r < c_in) {
            if (!odd) { tile_of(r, 160, kt, nt); t.W = a.in[I_EWIN] + (size_t)li * 2048 * EVEN_IN; t.ldw = EVEN_IN; t.WT = (bf16*)(ws + WS_WEIN) + (size_t)li * EVEN_IN * 2048; t.ldk = 2048; t.k0 = 64 * kt; t.n0 = 32 * nt; }
            else { tile_of(r, 192, kt, nt); t.W = a.in[I_OWIN] + (size_t)li * 2048 * 6144; t.ldw = 6144; t.WT = (bf16*)(ws + WS_WOIN) + (size_t)li * ODD_INP * 2048; t.ldk = 2048; t.k0 = 64 * kt; t.n0 = 32 * nt; }
            t.dn0 = t.n0; return t; } r -= c_in;
        if (r < c_out) { tile_of(r, 64, kt, nt); t.W = a.in[odd ? I_OWOUT : I_EWOUT] + (size_t)li * 2048 * 2048; t.ldw = 2048; t.WT = (bf16*)(ws + (odd ? WS_WOOUT : WS_WEOUT)) + (size_t)li * 2048 * 2048; t.ldk = 2048; t.k0 = 64 * kt; t.n0 = 32 * nt; t.dn0 = t.n0; return t; } r -= c_out;
        if (r < c_pool) { const int i = li * 4 + r / C_POOL, q = r % C_POOL; t.W = a.in[I_POOLW] + (size_t)i * 256 * 256; t.ldw = 256; t.WT = (bf16*)(ws + WS_WPOOL) + (size_t)i * 256 * 256; t.ldk = 256; t.k0 = 64 * (q / 8); t.n0 = 32 * (q % 8); t.dn0 = t.n0; t.nscale = a.in[I_POOLS] + (size_t)i * 256; return t; } r -= c_pool;
        if (r < c_up) { tile_of(r, 352, kt, nt); const int n0 = 32 * nt, half = n0 >= FF ? 1 : 0, ch0 = n0 - half * FF;
            t.W = a.in[I_WUP] + (size_t)l * 2048 * NUP; t.ldw = NUP; t.WT = (bf16*)(ws + WS_WUP) + (size_t)l * NUP * 2048; t.ldk = 2048; t.k0 = 64 * kt; t.n0 = n0; t.dn0 = 256 * (ch0 >> 7) + half * 128 + (ch0 & 127); return t; } r -= c_up;
        tile_of(r, 64, kt, nt); t.W = a.in[I_WDN] + (size_t)l * FF * 2048; t.ldw = 2048; t.WT = (bf16*)(ws + WS_WDN) + (size_t)l * 2048 * FF; t.ldk = FF; t.k0 = 64 * kt; t.n0 = 32 * nt; t.dn0 = t.n0; return t;
    };
    f32x4 w0[8], w1[8], w2[8], w3[8]; TrItem t0, t1, t2, t3;
    const int full4 = (nitems / nw) & ~3;
    if (full4 >= 4) {
        t0 = decode(widx); tr_load(t0, lane, w0); t1 = decode(widx + nw); tr_load(t1, lane, w1); t2 = decode(widx + 2 * nw); tr_load(t2, lane, w2);
        for (int k = 0; k + 4 < full4; k += 4) {
            t3 = decode(widx + (k + 3) * nw); tr_load(t3, lane, w3); tr_finish(t0, w0, scr, lane);
            t0 = decode(widx + (k + 4) * nw); tr_load(t0, lane, w0); tr_finish(t1, w1, scr, lane);
            t1 = decode(widx + (k + 5) * nw); tr_load(t1, lane, w1); tr_finish(t2, w2, scr, lane);
            t2 = decode(widx + (k + 6) * nw); tr_load(t2, lane, w2); tr_finish(t3, w3, scr, lane);
        }
        t3 = decode(widx + (full4 - 1) * nw); tr_load(t3, lane, w3);
        tr_finish(t0, w0, scr, lane); tr_finish(t1, w1, scr, lane); tr_finish(t2, w2, scr, lane); tr_finish(t3, w3, scr, lane);
    }
    { const int r0 = widx + full4 * nw, r1 = r0 + nw, r2 = r1 + nw, r3 = r2 + nw;
      if (r0 < nitems) { t0 = decode(r0); tr_load(t0, lane, w0); }
      if (r1 < nitems) { t1 = decode(r1); tr_load(t1, lane, w1); }
      if (r2 < nitems) { t2 = decode(r2); tr_load(t2, lane, w2); }
      if (r3 < nitems) { t3 = decode(r3); tr_load(t3, lane, w3); }
      if (r0 < nitems) tr_finish(t0, w0, scr, lane);
      if (r1 < nitems) tr_finish(t1, w1, scr, lane);
      if (r2 < nitems) tr_finish(t2, w2, scr, lane);
      if (r3 < nitems) tr_finish(t3, w3, scr, lane); }
    if (extras && odd && (parts & 1)) {
        for (int idx = tidx; idx < 2 * 2048 * 16; idx += nthreads) { const int r = idx & 15, k = (idx >> 4) & 2047, x = idx >> 15;
            ((bf16*)(ws + WS_WOIN))[((size_t)li * ODD_INP + 6144 + x * 16 + r) * 2048 + k] = (bf16)f2bf(a.in[I_GW1][(size_t)li * 2 * 2048 * 16 + idx]); }
        unsigned zu = 0u; asm volatile("" : "+v"(zu));
        for (int idx = tidx; idx < 224 * 2048 / 8; idx += nthreads)
            *(u32x4*)((bf16*)(ws + WS_WOIN) + ((size_t)li * ODD_INP + 6176) * 2048 + (size_t)idx * 8) = (u32x4){zu, zu, zu, zu};
    }
}

__device__ __forceinline__ void p0_prologue(const Args& a, unsigned char* ws, LAS unsigned char* lds, int tid, int lane, int wave, int G, int bid) {
    {
        LAS float* sil = (LAS float*)lds;
        LAS float* red = (LAS float*)(lds + 24576);
        for (int idx = tid; idx < 3 * 2048; idx += 512) { const int cv = idx >> 11, k = idx & 2047; const float v = cv == 0 ? a.in[I_CCTX][k] : a.in[I_C][(cv - 1) * 2048 + k]; sil[idx] = v * sigmoidf_(v); }
        __syncthreads();
        float* MOD = (float*)(ws + WS_MOD);
        const int kq = tid >> 4, c4 = tid & 15;
        for (int it = bid; it < 4 * 192; it += G) {
            const int l = it / 192, n0 = (it % 192) * 64;
            const float* wp = a.in[I_ADAW] + (size_t)l * 2048 * 12288 + n0 + 4 * c4;
            f32x4 a0 = {0.f, 0.f, 0.f, 0.f}, a1 = a0, a2 = a0;
#pragma unroll 8
            for (int k = kq; k < 2048; k += 32) { const f32x4 w = *(const f32x4*)(wp + (size_t)k * 12288); a0 += sil[k] * w; a1 += sil[2048 + k] * w; a2 += sil[4096 + k] * w; }
            *(LAS f32x4*)(red + (kq * 3 + 0) * 64 + 4 * c4) = a0; *(LAS f32x4*)(red + (kq * 3 + 1) * 64 + 4 * c4) = a1; *(LAS f32x4*)(red + (kq * 3 + 2) * 64 + 4 * c4) = a2;
            __syncthreads();
            if (tid < 192) { const int cv = tid >> 6, col = tid & 63; float s = 0.f;
#pragma unroll 8
                for (int q = 0; q < 32; ++q) s += red[(q * 3 + cv) * 64 + col];
                MOD[(size_t)(l * 3 + cv) * 12288 + n0 + col] = s + a.in[I_ADAB][(size_t)l * 12288 + n0 + col]; }
            __syncthreads();
        }
    }
    __syncthreads();
    for (int l = 0; l < (CONV_IN_PROLOGUE ? 4 : 1); ++l) convert_layer(a, ws, (LAS float*)(lds + wave * 16384), l, CONV_IN_PROLOGUE ? 3 : 1, 0, 1 << 30, true, bid * NWAVES + wave, G * NWAVES, lane, bid * 512 + tid, G * 512);
}

__device__ __forceinline__ float fast_logsig(float z) { return -__logf(1.0f + __expf(-z)); }
__device__ __forceinline__ u32x4 pack8(const float (&v)[8]) { return (u32x4){pk2(v[0], v[1]), pk2(v[2], v[3]), pk2(v[4], v[5]), pk2(v[6], v[7])}; }
__device__ __forceinline__ void unpack8(const u32x4 w, float (&v)[8]) { v[0] = bflo(w.x); v[1] = bfhi(w.x); v[2] = bflo(w.y); v[3] = bfhi(w.y); v[4] = bflo(w.z); v[5] = bfhi(w.z); v[6] = bflo(w.w); v[7] = bfhi(w.w); }
template <int MODE, bool XBF>
__device__ __forceinline__ void norm_phase(const float* xc, const float* xs, const bf16* xb, const float* g, const float* sh, const float* sc, bf16* H, float* out, int lane, int wave, int G, int bid) {
    const int gw = bid * NWAVES + wave, NGW = G * NWAVES;
    constexpr int NX = XBF ? 4 : 8;
    u32x4 nxa[NX], nxb[NX], nxc[NX];
#define NORM_FETCH(row_, nx) do { const int r_ = (row_); \
        if (XBF) { _Pragma("unroll") for (int jj = 0; jj < 4; ++jj) nx[jj] = *(const u32x4*)(xb + (size_t)r_ * D + 8 * (lane + 64 * jj)); } \
        else { const float* xr = r_ < NCTX ? xc + (size_t)r_ * D : xs + (size_t)(r_ - NCTX) * D; \
            _Pragma("unroll") for (int jj = 0; jj < 4; ++jj) { nx[2 * jj] = *(const u32x4*)(xr + 8 * (lane + 64 * jj)); nx[2 * jj + 1] = *(const u32x4*)(xr + 8 * (lane + 64 * jj) + 4); } } } while (0)
    if (gw < M) NORM_FETCH(gw, nxa);
    if (gw + NGW < M) NORM_FETCH(gw + NGW, nxb);
    if (gw + 2 * NGW < M) NORM_FETCH(gw + 2 * NGW, nxc);
    f32x4 gs[8], s0[8]; int cvcur = -1;
    auto process = [&](const int row, u32x4 (&nx)[NX]) {
        const int cv = row < NCTX ? 0 : 1 + ((row - NCTX) >> 12);
        f32x4 v[8]; float ss = 0.f;
        if (XBF) {
#pragma unroll
            for (int jj = 0; jj < 4; ++jj) { float t[8]; unpack8(nx[jj], t);
                v[2 * jj] = (f32x4){t[0], t[1], t[2], t[3]}; v[2 * jj + 1] = (f32x4){t[4], t[5], t[6], t[7]}; }
        } else {
#pragma unroll
            for (int j = 0; j < 8; ++j) v[j] = __builtin_bit_cast(f32x4, nx[j]); }
        if (row + 3 * NGW < M) NORM_FETCH(row + 3 * NGW, nx);
        if (cv != cvcur) { cvcur = cv;
#pragma unroll
            for (int jj = 0; jj < 4; ++jj)
#pragma unroll
                for (int e = 0; e < 2; ++e) { const int col = 8 * (lane + 64 * jj) + 4 * e; const f32x4 gg = *(const f32x4*)(g + col);
                    if (MODE == 0) { gs[2 * jj + e] = gg * (1.0f + *(const f32x4*)(sc + (size_t)cv * 12288 + col)); s0[2 * jj + e] = *(const f32x4*)(sh + (size_t)cv * 12288 + col); }
                    else gs[2 * jj + e] = gg; } }
        asm volatile("" ::: "memory");
#pragma unroll
        for (int j = 0; j < 8; ++j) ss += (v[j].x * v[j].x + v[j].y * v[j].y) + (v[j].z * v[j].z + v[j].w * v[j].w);
        const float rstd = 1.0f / sqrtf(wave_sum(ss, lane) * (1.f / D) + EPS);
#pragma unroll
        for (int jj = 0; jj < 4; ++jj) { const int col = 8 * (lane + 64 * jj);
            f32x4 h[2];
#pragma unroll
            for (int e = 0; e < 2; ++e) { if (MODE == 0) h[e] = v[2 * jj + e] * rstd * gs[2 * jj + e] + s0[2 * jj + e]; else h[e] = v[2 * jj + e] * rstd * gs[2 * jj + e]; }
            if (MODE == 0) *(u32x4*)(H + (size_t)row * D + col) = (u32x4){pk2(h[0].x, h[0].y), pk2(h[0].z, h[0].w), pk2(h[1].x, h[1].y), pk2(h[1].z, h[1].w)};
            else { *(f32x4*)(out + (size_t)row * D + col) = h[0]; *(f32x4*)(out + (size_t)row * D + col + 4) = h[1]; } }
    };
    for (int row = gw; row < M; row += 3 * NGW) {
        process(row, nxa);
        if (row + NGW < M) process(row + NGW, nxb);
        if (row + 2 * NGW < M) process(row + 2 * NGW, nxc);
    }
#undef NORM_FETCH
}

__device__ __forceinline__ void tr_store2(const LAS bf16* tile, int cp, int i0, bf16* dst0, bf16* dst1, const float (&sc)[8], int swz = 0) {
    float lo[8], hi[8];
#pragma unroll
    for (int ii = 0; ii < 8; ++ii) { const unsigned w = *(const LAS unsigned*)(tile + (i0 + ii) * 264 + ((((cp >> 2) ^ swz) << 3) + ((2 * cp) & 7))); lo[ii] = bflo(w) * sc[ii]; hi[ii] = bfhi(w) * sc[ii]; }
    *(u32x4*)dst0 = pack8(lo); *(u32x4*)dst1 = pack8(hi);
}

__device__ __forceinline__ void prep_ret(const Args& a, unsigned char* ws, LAS unsigned char* lds, int il, int tid, int lane, int wave, int G, int bid) {
    float zf_ = 0.f; asm volatile("" : "+v"(zf_)); const f32x4 Z4 = {zf_, zf_, zf_, zf_};
    constexpr int PADR = 264;
    LAS bf16* lq = (LAS bf16*)lds; LAS bf16* lk = lq + 64 * PADR; LAS bf16* lv = lk + 64 * PADR; LAS bf16* sAM = lv + 64 * PADR;
    const bf16* PROJ = (const bf16*)(ws + WS_PROJ);
    bf16* QD = (bf16*)(ws + WS_QD); bf16* KTT = (bf16*)(ws + WS_KTT); bf16* AM = (bf16*)(ws + WS_AM); float* DEC = (float*)(ws + WS_DEC); bf16* VT = (bf16*)(ws + WS_VT);
    const int cg = bid & 3;
    const float Lf0 = logsigmoidf_(a.in[I_RDEC][(il * 2 + 0) * 8 + cg * 2]), Lf1 = logsigmoidf_(a.in[I_RDEC][(il * 2 + 0) * 8 + cg * 2 + 1]);
    const float Lb0 = logsigmoidf_(a.in[I_RDEC][(il * 2 + 1) * 8 + cg * 2]), Lb1 = logsigmoidf_(a.in[I_RDEC][(il * 2 + 1) * 8 + cg * 2 + 1]);
#define LF(hh) ((hh) ? Lf1 : Lf0)
#define LB(hh) ((hh) ? Lb1 : Lb0)
    u32x4 q1[2], q2[2], k1[2], k2[2], vv[4];
#define RET_FETCH(it_) do { const int row0_ = ((it_) >> 2) * 64; \
        _Pragma("unroll") for (int j = 0; j < 2; ++j) { const int pp = tid + 512 * j, row = pp >> 4, pq = pp & 15, p = (pq & 3) + 8 * (pq >> 2); \
            const bf16* base = PROJ + (size_t)(row0_ + row) * EVEN_IN + cg * 256 + 8 * p; \
            q1[j] = *(const u32x4*)(base + 1024); q2[j] = *(const u32x4*)(base + 1024 + 32); k1[j] = *(const u32x4*)(base + 2048); k2[j] = *(const u32x4*)(base + 2048 + 32); } \
        _Pragma("unroll") for (int j = 0; j < 4; ++j) { const int p = tid + 512 * j, row = p >> 5, pc = p & 31; vv[j] = *(const u32x4*)(PROJ + (size_t)(row0_ + row) * EVEN_IN + 3072 + cg * 256 + 8 * pc); } } while (0)
    if (bid < 768) RET_FETCH(bid);
    for (int it = bid; it < 768; it += G) {
        const int c = it >> 2, row0 = c * 64; const bool smp = c >= 64; const int cis = smp ? ((c - 64) & 63) : (c & 3);
        __syncthreads();
#pragma unroll
        for (int j = 0; j < 2; ++j) { const int pp = tid + 512 * j, row = pp >> 4, pq = pp & 15, p = (pq & 3) + 8 * (pq >> 2);
            const int d0 = 8 * p, hh = d0 >> 7, ax = (d0 >> 6) & 1, f0 = d0 & 31;
            float x1[8], x2[8], y1[8], y2[8]; unpack8(q1[j], x1); unpack8(q2[j], x2); unpack8(k1[j], y1); unpack8(k2[j], y2);
            if (smp) { const float pos = (float)(ax ? row : cis), a0 = pos * __builtin_amdgcn_exp2f(-(float)f0 * (13.287712379549449f / 32.f));
                constexpr float RI[8] = {1.0f, 0.7498942093324559f, 0.5623413251903491f, 0.4216965034285822f, 0.31622776601683794f, 0.23713737056616552f, 0.1778279410038923f, 0.1333521432163324f};
#pragma unroll
                for (int e = 0; e < 8; ++e) { const float ang = a0 * RI[e]; const float cs = __cosf(ang), sn = __sinf(ang);
                    const float a1 = x1[e] * cs - x2[e] * sn, a2 = x1[e] * sn + x2[e] * cs, b1 = y1[e] * cs - y2[e] * sn, b2 = y1[e] * sn + y2[e] * cs;
                    x1[e] = a1; x2[e] = a2; y1[e] = b1; y2[e] = b2; } }
#pragma unroll
            for (int e = 0; e < 8; ++e) { y1[e] *= 0.08838834764831845f; y2[e] *= 0.08838834764831845f; }
            *(LAS u32x4*)(lq + row * PADR + d0) = pack8(x1); *(LAS u32x4*)(lq + row * PADR + d0 + 32) = pack8(x2);
            *(LAS u32x4*)(lk + row * PADR + d0) = pack8(y1); *(LAS u32x4*)(lk + row * PADR + d0 + 32) = pack8(y2);
            { bf16* qf = QD + ((size_t)0 * M + row0 + row) * 1024 + cg * 256 + d0; *(u32x4*)qf = pack8(x1); *(u32x4*)(qf + 32) = pack8(x2); }
            asm volatile("" ::: "memory"); }
#pragma unroll
        for (int j = 0; j < 4; ++j) { int p = tid + 512 * j; asm volatile("" : "+v"(p));
            const int row = p >> 5, pc = p & 31; *(LAS u32x4*)(lv + row * PADR + 8 * (pc ^ ((row >> 3) & 7))) = vv[j]; }
        { const int dp = tid >> 8, d = tid & 255, hh = d >> 7; DEC[((size_t)dp * NCHUNK + c) * 1024 + cg * 256 + d] = __expf(64.f * (dp ? LB(hh) : LF(hh))); }
        if (it + G < 768) RET_FETCH(it + G);
        __syncthreads();
        { const float one[8] = {1.f, 1.f, 1.f, 1.f, 1.f, 1.f, 1.f, 1.f};
#pragma unroll
          for (int j = 0; j < 2; ++j) { const int t = tid + 512 * j, cp = t & 127, i0 = (t >> 7) * 8;
              bf16* dst = KTT + ((size_t)c * 1024 + cg * 256 + 2 * cp) * 64 + i0; tr_store2(lk, cp, i0, dst, dst + 64, one); } }
        { const float one[8] = {1.f, 1.f, 1.f, 1.f, 1.f, 1.f, 1.f, 1.f};
#pragma unroll
          for (int j = 0; j < 2; ++j) { const int t = tid + 512 * j, i0 = (t & 7) * 8, cp = t >> 3;
              bf16* dst = VT + ((size_t)c * 1024 + cg * 256 + 2 * cp) * 64 + i0; tr_store2(lv, cp, i0, dst, dst + 64, one, (i0 >> 3) & 7); } }
        { const int fr = lane & 15, fq = lane >> 4;
          for (int p = wave; p < 32; p += 8) { const int tj = p & 3, ti = (p >> 2) & 3, hh = p >> 4;
              f32x4 acc = Z4; bf16x8 av[4], bv[4];
#pragma unroll
              for (int ks2 = 0; ks2 < 4; ++ks2) { av[ks2] = *(const LAS bf16x8*)(lq + (16 * ti + fr) * PADR + hh * 128 + 32 * ks2 + 8 * fq); bv[ks2] = *(const LAS bf16x8*)(lk + (16 * tj + fr) * PADR + hh * 128 + 32 * ks2 + 8 * fq); }
              __builtin_amdgcn_sched_barrier(0);
#pragma unroll
              for (int ks2 = 0; ks2 < 4; ++ks2) acc = __builtin_amdgcn_mfma_f32_16x16x32_bf16(av[ks2], bv[ks2], acc, 0, 0, 0);
              __builtin_amdgcn_sched_barrier(0);
#pragma unroll
              for (int r = 0; r < 4; ++r) { const int i = 16 * ti + 4 * fq + r, j = 16 * tj + fr;
                  sAM[((0 * 2 + hh) * 64 + i) * 72 + j] = (unsigned short)f2bf(j <= i ? acc[r] * __expf(LF(hh) * (float)(i - j)) : 0.f);
                  sAM[((1 * 2 + hh) * 64 + i) * 72 + j] = (unsigned short)f2bf(j >= i ? acc[r] * __expf(LB(hh) * (float)(j - i)) : 0.f); } } }
        __syncthreads();
#pragma unroll
        for (int j = 0; j < 4; ++j) { const int row = tid >> 3, pc = tid & 7, dp = j >> 1, hh = j & 1;
            *(u32x4*)(AM + ((((size_t)dp * NCHUNK + c) * 8 + cg * 2 + hh) * 64 + row) * 64 + 8 * pc) = *(const LAS u32x4*)(sAM + (j * 64 + row) * 72 + 8 * pc); }
    }
    for (int it = bid; it < 192; it += G) {
        const int c = it, row0 = c * 64; const bool smp = c >= 64; const int cis = smp ? ((c - 64) & 63) : (c & 3);
        const int T = smp ? 4096 : 256, t0 = cis * 64, srow0 = row0 - t0;
        bf16* POOLED = (bf16*)(ws + WS_POOLED);
        const int cl = tid & 31, ir = tid >> 5;
#pragma unroll
        for (int gi = 0; gi < 4; ++gi) {
            const int win = 2 << gi, hw = win >> 1, IPB = win <= 4 ? 4 : 16 / win;
            const bf16* up = PROJ + (size_t)srow0 * EVEN_IN + 8 * (gi * 32 + cl);
#pragma unroll
            for (int ip0 = 0; ip0 < 4; ip0 += IPB) {
                u32x4 x[16];
#pragma unroll
                for (int q = 0; q < IPB; ++q)
#pragma unroll
                    for (int j = 0; j < win; ++j) { int r = t0 + ir + 16 * (ip0 + q) - hw + j; r = r < 0 ? 0 : (r > T - 1 ? T - 1 : r); x[q * win + j] = *(const u32x4*)(up + (size_t)r * EVEN_IN); }
                asm volatile("" ::: "memory");
#pragma unroll
                for (int q = 0; q < IPB; ++q) {
                    const int i = ir + 16 * (ip0 + q), t = t0 + i;
                    int lo = t - hw; lo = lo < 0 ? 0 : lo; int hi = t + win - hw; hi = hi > T ? T : hi;
                    float s[8] = {0.f, 0.f, 0.f, 0.f, 0.f, 0.f, 0.f, 0.f}, u[8] = {0.f, 0.f, 0.f, 0.f, 0.f, 0.f, 0.f, 0.f};
#pragma unroll
                    for (int j = 0; j < win; ++j) { const int r = t - hw + j; const bool ok = (unsigned)r < (unsigned)T; float v[8]; unpack8(x[q * win + j], v);
#pragma unroll
                        for (int e = 0; e < 8; ++e) { s[e] += ok ? v[e] : 0.f; if (j == hw) u[e] = v[e]; } }
                    const float inv = 1.0f / (float)(hi - lo); float o[8];
#pragma unroll
                    for (int e = 0; e < 8; ++e) o[e] = s[e] * inv - u[e];
                    *(u32x4*)(POOLED + (size_t)(row0 + i) * 1024 + 8 * (gi * 32 + cl)) = pack8(o);
                }
            }
        }
    }
}
#undef LF
#undef RET_FETCH
#undef LB

__device__ __forceinline__ void prep_gla(const Args& a, unsigned char* ws, LAS unsigned char* lds, int jl, int tid, int lane, int wave, int G, int bid) {
    float zf_ = 0.f; asm volatile("" : "+v"(zf_)); const f32x4 Z4 = {zf_, zf_, zf_, zf_};
    constexpr int PADR = 264;
    LAS bf16* lq = (LAS bf16*)lds; LAS bf16* lk = lq + 64 * PADR; LAS bf16* lv = lk + 64 * PADR; LAS bf16* sAM = lv + 64 * PADR;
    LAS float* zl = (LAS float*)(sAM + 64 * 72); LAS float* tot = zl + 64 * 32;
    const bf16* PROJ = (const bf16*)(ws + WS_PROJ);
    bf16* QD = (bf16*)(ws + WS_QD); bf16* KTT = (bf16*)(ws + WS_KTT); bf16* AM = (bf16*)(ws + WS_AM); float* DEC = (float*)(ws + WS_DEC); bf16* VT = (bf16*)(ws + WS_VT);
    const int th = tid >> 8, d = tid & 255;
    const int cg = (bid >> 1) & 3, dir = bid & 1, col = cg * 256 + d;
    float gw2[16];
#pragma unroll
    for (int r = 0; r < 16; ++r) gw2[r] = a.in[I_GW2][((size_t)(jl * 2 + dir) * 16 + r) * 1024 + col];
    const float gbv = a.in[I_GB][(size_t)(jl * 2 + dir) * 1024 + col];
    typedef float f32x2 __attribute__((ext_vector_type(2)));
    f32x2 g2[8]; const float gbs = gbv * -1.4426950408889634f;
#pragma unroll
    for (int r = 0; r < 8; ++r) g2[r] = (f32x2){gw2[2 * r] * -1.4426950408889634f, gw2[2 * r + 1] * -1.4426950408889634f};
    u32x4 qv[4], kv[4], vv[4]; f32x4 zv;
#define GLA_FETCH(it_) do { const int row0_ = ((it_) >> 3) * 64; \
        _Pragma("unroll") for (int j = 0; j < 4; ++j) { const int p = tid + 512 * j, row = p >> 5, pc = p & 31; const bf16* base = PROJ + (size_t)(row0_ + row) * ODD_INP + 8 * pc; \
            qv[j] = *(const u32x4*)(base + cg * 256); kv[j] = *(const u32x4*)(base + 1024 + cg * 256); vv[j] = *(const u32x4*)(base + 2048 + cg * 512 + dir * 256); } \
        zv = *(const f32x4*)((const float*)(ws + WS_Z1) + (size_t)row0_ * 32 + 4 * tid); } while (0)
    if (bid < 1536) GLA_FETCH(bid);
    for (int it = bid; it < 1536; it += G) {
        const int c = it >> 3, row0 = c * 64;
        __syncthreads();
#pragma unroll
        for (int j = 0; j < 4; ++j) { const int p = tid + 512 * j, row = p >> 5, pc = p & 31;
            *(LAS u32x4*)(lq + row * PADR + 8 * pc) = qv[j]; *(LAS u32x4*)(lk + row * PADR + 8 * pc) = kv[j]; *(LAS u32x4*)(lv + row * PADR + 8 * (pc ^ ((row >> 3) & 7))) = vv[j]; }
        *(LAS f32x4*)(zl + 4 * tid) = zv;
        if (it + G < 1536) GLA_FETCH(it + G);
        __syncthreads();
        float lg[32]; float Tsum = 0.f;
#pragma unroll
        for (int i4 = 0; i4 < 32; i4 += 2) { f32x4 zz[2][4];
#pragma unroll
            for (int t4 = 0; t4 < 2; ++t4) { const LAS f32x4* zp = (const LAS f32x4*)(zl + (32 * th + i4 + t4) * 32 + dir * 16);
#pragma unroll
                for (int r4 = 0; r4 < 4; ++r4) zz[t4][r4] = zp[r4]; }
            __builtin_amdgcn_sched_barrier(0);
#pragma unroll
            for (int t4 = 0; t4 < 2; ++t4) { const int ii = i4 + t4; f32x2 za = {gbs, 0.f};
#pragma unroll
                for (int r4 = 0; r4 < 4; ++r4) { za = __builtin_elementwise_fma((f32x2){zz[t4][r4].x, zz[t4][r4].y}, g2[2 * r4], za); za = __builtin_elementwise_fma((f32x2){zz[t4][r4].z, zz[t4][r4].w}, g2[2 * r4 + 1], za); }
                lg[ii] = __builtin_amdgcn_logf(1.0f + __builtin_amdgcn_exp2f(za.x + za.y)) * (-1.f / 16.f); Tsum += lg[ii]; }
            __builtin_amdgcn_sched_barrier(0); }
        tot[th * 256 + d] = Tsum;
        __syncthreads();
        const float T0 = tot[d], Gt = T0 + tot[256 + d];
        float P = th ? T0 : 0.f;
#pragma unroll
        for (int g8 = 0; g8 < 4; ++g8) { float ktv[8];
            unsigned short qs[8], ks[8];
#pragma unroll
            for (int e = 0; e < 8; ++e) { const int i = 32 * th + 8 * g8 + e; qs[e] = lq[i * PADR + d]; ks[e] = lk[i * PADR + d]; }
            __builtin_amdgcn_sched_barrier(0);
#pragma unroll
            for (int e = 0; e < 8; ++e) { const int ii = 8 * g8 + e, i = 32 * th + ii; P += lg[ii]; const float Gi = dir ? (Gt - P + lg[ii]) : P;
                const float q = bf2f(qs[e]), k = bf2f(ks[e]);
                lq[i * PADR + d] = (unsigned short)f2bf(q * 0.0625f * __builtin_amdgcn_exp2f(Gi)); lk[i * PADR + d] = (unsigned short)f2bf(k * __builtin_amdgcn_exp2f(-Gi)); ktv[e] = k * __builtin_amdgcn_exp2f(Gt - Gi); }
            __builtin_amdgcn_sched_barrier(0);
            *(u32x4*)(KTT + (((size_t)dir * NCHUNK + c) * 1024 + col) * 64 + 32 * th + 8 * g8) = pack8(ktv); }
        if (th == 0) DEC[((size_t)dir * NCHUNK + c) * 1024 + col] = __builtin_amdgcn_exp2f(Gt);
        __syncthreads();
#pragma unroll
        for (int j = 0; j < 4; ++j) { const int p = tid + 512 * j, row = p >> 5, pc = p & 31;
            *(u32x4*)(QD + ((size_t)dir * M + row0 + row) * 1024 + cg * 256 + 8 * pc) = *(const LAS u32x4*)(lq + row * PADR + 8 * pc); }
        { const float one[8] = {1.f, 1.f, 1.f, 1.f, 1.f, 1.f, 1.f, 1.f};
#pragma unroll
          for (int j = 0; j < 2; ++j) { const int t = tid + 512 * j, i0 = (t & 7) * 8, cp = t >> 3;
              bf16* dst = VT + ((size_t)c * 2048 + cg * 512 + dir * 256 + 2 * cp) * 64 + i0; tr_store2(lv, cp, i0, dst, dst + 64, one, (i0 >> 3) & 7); } }
        { const int fr = lane & 15, fq = lane >> 4;
#pragma unroll
          for (int j2 = 0; j2 < 2; ++j2) { const int p = wave + 8 * j2, tj = p & 3, ti = p >> 2;
              f32x4 acc = Z4; bf16x8 av[8], bv[8];
#pragma unroll
              for (int ks2 = 0; ks2 < 8; ++ks2) { av[ks2] = *(const LAS bf16x8*)(lq + (16 * ti + fr) * PADR + 32 * ks2 + 8 * fq); bv[ks2] = *(const LAS bf16x8*)(lk + (16 * tj + fr) * PADR + 32 * ks2 + 8 * fq); }
              __builtin_amdgcn_sched_barrier(0);
#pragma unroll
              for (int ks2 = 0; ks2 < 8; ++ks2) acc = __builtin_amdgcn_mfma_f32_16x16x32_bf16(av[ks2], bv[ks2], acc, 0, 0, 0);
              __builtin_amdgcn_sched_barrier(0);
#pragma unroll
              for (int r = 0; r < 4; ++r) { const int i = 16 * ti + 4 * fq + r, j = 16 * tj + fr; const bool keep = dir ? (j >= i) : (j <= i);
                  sAM[i * 72 + j] = (unsigned short)f2bf(keep ? acc[r] : 0.f); } } }
        __syncthreads();
        { const int row = tid >> 3, pc = tid & 7;
          *(u32x4*)(AM + ((((size_t)dir * NCHUNK + c) * 8 + cg) * 64 + row) * 64 + 8 * pc) = *(const LAS u32x4*)(sAM + row * 72 + 8 * pc); }
    }
#undef GLA_FETCH
}

__device__ __forceinline__ unsigned cvt_pk_nv(float lo, float hi) { unsigned r; asm("v_cvt_pk_bf16_f32 %0, %1, %2" : "=v"(r) : "v"(lo), "v"(hi)); return r; }
template <int DK, int NH, int DVH>
__device__ __forceinline__ void scan_phase(unsigned char* ws, LAS unsigned char* lds, int li, const float* state_in, float* state_out, const float* rdec, int tid, int lane, int wave, int G, int bid) {
    constexpr int NSL = DVH / 64, NT2 = DK / 32, NVT = NH * DVH, QS = DK + 16, KS = 80, AS = 80, HK = DK / 2;
    constexpr int KB_ = DK <= 128 ? 2 : 4, TB_ = 4;
    constexpr int NPQ = DK / 64, NPK = DK / 64;
    LAS bf16* sQ = (LAS bf16*)lds; LAS bf16* sK = sQ + 64 * QS; LAS bf16* sA = sK + DK * KS; LAS bf16* sV = sA + 64 * AS; LAS float* sD = (LAS float*)(sV + 64 * KS); LAS f32x4* sO = (LAS f32x4*)(sD + DK); LAS bf16* sOut = (LAS bf16*)(sO + 8 * 2 * 64);
    const bf16* QD = (const bf16*)(ws + WS_QD); const bf16* KTT = (const bf16*)(ws + WS_KTT); const bf16* AM = (const bf16*)(ws + WS_AM); const float* DEC = (const float*)(ws + WS_DEC); const bf16* VT = (const bf16*)(ws + WS_VT);
    bf16* O = (bf16*)(ws + WS_O);
    constexpr int n_long = 2 * NH * 2 * NSL, n_short = 16 * NH * 2 * NSL;
    const int fr = lane & 15, fq = lane >> 4, wv = wave & 3, wk = wave >> 2;
    float zf_ = 0.f; asm volatile("" : "+v"(zf_)); const f32x4 Z4 = {zf_, zf_, zf_, zf_};
    int oq[NPQ], lq_[NPQ];
#pragma unroll
    for (int j = 0; j < NPQ; ++j) { const int p = tid + 512 * j, row = p / (DK / 8), pc = p % (DK / 8); oq[j] = row * 1024 + 8 * pc;
        lq_[j] = row * QS + 32 * (pc >> 2) + ((pc & 3) < 2 ? 16 * (pc & 3) : 16 * ((pc & 3) - 2) + 4); }
    const int ok0 = tid * 8, lk0 = (tid >> 3) * KS + 8 * (tid & 7);
    const bool split = (G > n_long) && (G % 8 == 0);
    int q = bid, qstep = G, qend = n_long + n_short;
    if (split) { if (bid < n_long) { qend = n_long; } else { q = n_long + (bid - n_long); qstep = G - n_long; } }
    for (; q < qend; q += qstep) {
        const bool is_long = q < n_long; const int idx = is_long ? q : q - n_long;
        const int x8 = idx & 7, j8 = idx >> 3, sl = j8 % NSL, combo = x8 + 8 * (j8 / NSL);
        const int dir = combo & 1, head = (combo >> 1) % NH, sb = combo / (2 * NH);
        const int cbase = is_long ? 64 + sb * 64 : 4 * sb, nch = is_long ? 64 : 4;
        const int ecol0 = sl * 64 + 16 * wv + fr;
        const int qdir = DK <= 128 ? 0 : dir;
        float bq_ = 1.f, bk_ = 1.f, r1_ = 1.f, r16_ = 1.f, rk1_ = 1.f, rk32_ = 1.f;
        if constexpr (DK <= 128) { const float L2 = logsigmoidf_(rdec[(li * 2 + dir) * 8 + head]) * 1.4426950408889634f, sL = dir ? -L2 : L2;
            bq_ = __builtin_amdgcn_exp2f(L2 * (float)(dir ? 64 - 4 * fq : 4 * fq + 1)); r1_ = __builtin_amdgcn_exp2f(sL); r16_ = __builtin_amdgcn_exp2f(16.f * sL);
            bk_ = __builtin_amdgcn_exp2f(L2 * (float)(dir ? 8 * fq : 63 - 8 * fq)); rk1_ = __builtin_amdgcn_exp2f(-sL); rk32_ = __builtin_amdgcn_exp2f(-32.f * sL); }
        f32x4 S[NT2];
        const unsigned sob = (unsigned)((wk * HK + 4 * fq) * DVH + ecol0);
        if (is_long) { const float* sp = state_in + ((((size_t)sb * 2 + li) * 2 + dir) * NH + head) * DK * DVH;
            unsigned sob1 = sob; asm volatile("" : "+v"(sob1));
#pragma unroll
            for (int t = 0; t < NT2; ++t)
#pragma unroll
                for (int r = 0; r < 4; ++r) S[t][r] = sp[sob1 + (unsigned)((16 * t + r) * DVH)]; }
        else {
#pragma unroll
            for (int t = 0; t < NT2; ++t) S[t] = Z4; }
        struct Pf { u32x4 q[NPQ], k[NPK], a, v; f32x4 d; } pfA, pfB;
#define SCAN_FETCH(c_, P) do { \
            const bf16* qb_ = QD + ((size_t)qdir * M + (size_t)(c_) * 64) * 1024 + head * DK; \
            const bf16* kb_ = KTT + (((size_t)qdir * NCHUNK + (c_)) * 1024 + head * DK) * 64; \
            const bf16* ab_ = AM + (((size_t)dir * NCHUNK + (c_)) * 8 + head) * 4096; \
            const bf16* vb_ = VT + ((size_t)(c_) * NVT + head * DVH + sl * 64) * 64; \
            _Pragma("unroll") for (int j = 0; j < NPQ; ++j) P.q[j] = *(const u32x4*)(qb_ + oq[j]); \
            _Pragma("unroll") for (int j = 0; j < NPK; ++j) P.k[j] = *(const u32x4*)(kb_ + ok0 + 4096 * j); \
            P.a = *(const u32x4*)(ab_ + ok0); \
            P.v = *(const u32x4*)(vb_ + ok0); \
            if (tid < DK / 4) P.d = *(const f32x4*)(DEC + ((size_t)dir * NCHUNK + (c_)) * 1024 + head * DK + 4 * tid); } while (0)
#define SCAN_TO_LDS(P) do { \
            _Pragma("unroll") for (int j = 0; j < NPQ; ++j) { *(LAS u32x2*)(sQ + lq_[j]) = (u32x2){P.q[j].x, P.q[j].y}; *(LAS u32x2*)(sQ + lq_[j] + 8) = (u32x2){P.q[j].z, P.q[j].w}; } \
            _Pragma("unroll") for (int j = 0; j < NPK; ++j) *(LAS u32x4*)(sK + lk0 + 64 * KS * j) = P.k[j]; \
            *(LAS u32x4*)(sA + lk0) = P.a; \
            *(LAS u32x4*)(sV + lk0) = P.v; \
            if (tid < DK / 4) *(LAS f32x4*)(sD + 4 * tid) = P.d; } while (0)
#define SCAN_CHUNK(s_) (cbase + (dir ? nch - 1 - (s_) : (s_)))
#define SCAN_STEP(s_, AHEAD, PN2, PN1) do { \
            const int row0 = SCAN_CHUNK(s_) * 64; \
            if ((AHEAD) == 2 && (s_) + 2 < nch) SCAN_FETCH(SCAN_CHUNK((s_) + 2), PN2); \
            f32x4 oacc[4]; \
            _Pragma("unroll") for (int t = 0; t < 4; ++t) oacc[t] = Z4; \
              \
              \
            static_assert(KB_ == DK / 64 && (NT2 == TB_ || NT2 == 2 * TB_), "one o_inter batch, one or two state batches"); \
            bf16x8 afr[KB_][4], vb[2], afA[4]; \
            _Pragma("unroll") for (int k = 0; k < KB_; ++k) _Pragma("unroll") for (int it = 0; it < 4; ++it) \
                afr[k][it] = *(const LAS bf16x8*)(sQ + (16 * it + fr) * QS + wk * HK + 32 * k + 8 * fq); \
            _Pragma("unroll") for (int kk = 0; kk < 2; ++kk) vb[kk] = *(const LAS bf16x8*)(sV + (16 * wv + fr) * KS + 32 * kk + 8 * fq); \
            _Pragma("unroll") for (int it = 0; it < 4; ++it) afA[it] = *(const LAS bf16x8*)(sA + (16 * it + fr) * AS + 32 * wk + 8 * fq); \
            __builtin_amdgcn_sched_barrier(0); \
              \
            _Pragma("unroll") for (int k = 0; k < KB_; ++k) { \
                const f32x4 s0 = S[2 * k], s1 = S[2 * k + 1]; \
                u32x4 bw; bw.x = cvt_pk_nv(s0[0], s0[1]); bw.y = cvt_pk_nv(s0[2], s0[3]); bw.z = cvt_pk_nv(s1[0], s1[1]); bw.w = cvt_pk_nv(s1[2], s1[3]); \
                const bf16x8 bfrag = __builtin_bit_cast(bf16x8, bw); \
                _Pragma("unroll") for (int it = 0; it < 4; ++it) oacc[it] = __builtin_amdgcn_mfma_f32_16x16x32_bf16(afr[k][it], bfrag, oacc[it], 0, 0, 0); } \
            __builtin_amdgcn_sched_barrier(0); \
            bf16x8 vs0 = vb[0], vs1 = vb[1]; \
            if constexpr (DK <= 128) { \
                { float qv_ = bq_; asm volatile("" : "+v"(qv_)); _Pragma("unroll") for (int it = 0; it < 4; ++it) { float v_ = qv_; _Pragma("unroll") for (int r = 0; r < 4; ++r) { oacc[it][r] *= v_; v_ *= r1_; } qv_ *= r16_; } } \
                { float f0[8], f1[8]; unpack8(__builtin_bit_cast(u32x4, vb[0]), f0); unpack8(__builtin_bit_cast(u32x4, vb[1]), f1); \
                  float k0_ = bk_; asm volatile("" : "+v"(k0_)); float k1_ = k0_ * rk32_; _Pragma("unroll") for (int e = 0; e < 8; ++e) { f0[e] *= k0_; f1[e] *= k1_; k0_ *= rk1_; k1_ *= rk1_; } \
                  vs0 = __builtin_bit_cast(bf16x8, pack8(f0)); vs1 = __builtin_bit_cast(bf16x8, pack8(f1)); } } \
            f32x4 dvA[TB_], dvB[TB_]; bf16x8 akA[TB_][2], akB[TB_][2]; \
              \
            _Pragma("unroll") for (int k = 0; k < TB_; ++k) dvA[k] = *(const LAS f32x4*)(sD + wk * HK + 16 * k + 4 * fq); \
            _Pragma("unroll") for (int k = 0; k < TB_; ++k) _Pragma("unroll") for (int kk = 0; kk < 2; ++kk) akA[k][kk] = *(const LAS bf16x8*)(sK + (wk * HK + 16 * k + fr) * KS + 32 * kk + 8 * fq); \
            __builtin_amdgcn_sched_barrier(0); \
              \
            _Pragma("unroll") for (int it = 0; it < 4; ++it) oacc[it] = __builtin_amdgcn_mfma_f32_16x16x32_bf16(afA[it], wk ? vb[1] : vb[0], oacc[it], 0, 0, 0); \
            __builtin_amdgcn_sched_barrier(0); \
              \
            _Pragma("unroll") for (int k = 0; k < TB_; ++k) S[k] = S[k] * dvA[k]; \
            if (NT2 > TB_) { _Pragma("unroll") for (int k = 0; k < TB_; ++k) { dvB[k] = *(const LAS f32x4*)(sD + wk * HK + 16 * (TB_ + k) + 4 * fq); \
                _Pragma("unroll") for (int kk = 0; kk < 2; ++kk) akB[k][kk] = *(const LAS bf16x8*)(sK + (wk * HK + 16 * (TB_ + k) + fr) * KS + 32 * kk + 8 * fq); } } \
              \
            _Pragma("unroll") for (int itl = 0; itl < 2; ++itl) sO[(wave * 2 + itl) * 64 + lane] = wk ? oacc[itl] : oacc[2 + itl]; \
            __builtin_amdgcn_sched_barrier(0); \
              \
            { f32x4 a0[TB_]; \
              _Pragma("unroll") for (int k = 0; k < TB_; ++k) a0[k] = __builtin_amdgcn_mfma_f32_16x16x32_bf16(akA[k][0], vs0, S[k], 0, 0, 0); \
              _Pragma("unroll") for (int k = 0; k < TB_; ++k) S[k] = __builtin_amdgcn_mfma_f32_16x16x32_bf16(akA[k][1], vs1, a0[k], 0, 0, 0); } \
            __builtin_amdgcn_sched_barrier(0); \
            if (NT2 > TB_) { f32x4 a0[TB_]; \
              _Pragma("unroll") for (int k = 0; k < TB_; ++k) a0[k] = __builtin_amdgcn_mfma_f32_16x16x32_bf16(akB[k][0], vs0, S[TB_ + k] * dvB[k], 0, 0, 0); \
              _Pragma("unroll") for (int k = 0; k < TB_; ++k) S[TB_ + k] = __builtin_amdgcn_mfma_f32_16x16x32_bf16(akB[k][1], vs1, a0[k], 0, 0, 0); \
              __builtin_amdgcn_sched_barrier(0); } \
            __syncthreads();                                         \
            if ((s_) + 1 < nch) SCAN_TO_LDS(PN1); \
            if ((AHEAD) == 1 && (s_) + 2 < nch) SCAN_FETCH(SCAN_CHUNK((s_) + 2), PN1);     \
            _Pragma("unroll") for (int itl = 0; itl < 2; ++itl) { const f32x4 mine = wk ? oacc[2 + itl] : oacc[itl]; const f32x4 o = mine + sO[((wave ^ 4) * 2 + itl) * 64 + lane]; \
                _Pragma("unroll") for (int r = 0; r < 4; ++r) sOut[(32 * wk + 16 * itl + 4 * fq + r) * AS + 16 * wv + fr] = (unsigned short)f2bf(o[r]); } \
            __syncthreads();                                         \
            *(u32x4*)(O + ((size_t)dir * M + row0 + (tid >> 3)) * 2048 + head * DVH + sl * 64 + 8 * (tid & 7)) = *(const LAS u32x4*)(sOut + (tid >> 3) * AS + 8 * (tid & 7)); \
        } while (0)
        __syncthreads();
        SCAN_FETCH(SCAN_CHUNK(0), pfA); SCAN_TO_LDS(pfA);
        if constexpr (DK <= 128) {
            if (nch > 1) SCAN_FETCH(SCAN_CHUNK(1), pfB);
            __syncthreads();
            for (int s = 0; s < nch; s += 2) {
                SCAN_STEP(s, 2, pfA, pfB);
                SCAN_STEP(s + 1, 2, pfB, pfA);
            }
        } else {
            if (nch > 1) SCAN_FETCH(SCAN_CHUNK(1), pfA);
            __syncthreads();
            for (int s = 0; s < nch; ++s) SCAN_STEP(s, 1, pfA, pfA);
        }
#undef SCAN_STEP
#undef SCAN_CHUNK
#undef SCAN_FETCH
#undef SCAN_TO_LDS
        if (!is_long) { float* sp = state_out + ((((size_t)sb * 2 + li) * 2 + dir) * NH + head) * DK * DVH;
            unsigned sob2 = sob; asm volatile("" : "+v"(sob2));
#pragma unroll
            for (int t = 0; t < NT2; ++t)
#pragma unroll
                for (int r = 0; r < 4; ++r) sp[sob2 + (unsigned)((16 * t + r) * DVH)] = S[t][r]; }
    }
}

template <int NV, int DVH>
__device__ __forceinline__ void post_phase(unsigned char* ws, const float* ng, int ldp, int cat0, int lane, int wave, int G, int bid) {
    const bf16* O = (const bf16*)(ws + WS_O); const bf16* PROJ = (const bf16*)(ws + WS_PROJ); bf16* CAT = (bf16*)(ws + WS_CAT);
    constexpr int VPL = NV / 64, LPH = DVH / VPL, NP = VPL / 8;
    const int gw = bid * NWAVES + wave, NGW = G * NWAVES;
    f32x4 ngr[VPL / 4];
#pragma unroll
    for (int j = 0; j < VPL / 4; ++j) ngr[j] = *(const f32x4*)(ng + lane * VPL + 4 * j);
    u32x4 paA[NP], pbA[NP], pgA[NP], paB[NP], pbB[NP], pgB[NP];
#define POST_FETCH(row_, pa, pb, pg) do { const int r_ = (row_); const bf16* o0 = O + (size_t)r_ * 2048 + lane * VPL; const bf16* o1 = o0 + (size_t)M * 2048; const bf16* gp = PROJ + (size_t)r_ * ldp + 4096 + lane * VPL; \
        _Pragma("unroll") for (int j = 0; j < NP; ++j) { pa[j] = *(const u32x4*)(o0 + 8 * j); pb[j] = *(const u32x4*)(o1 + 8 * j); pg[j] = *(const u32x4*)(gp + 8 * j); } } while (0)
    if (gw < M) POST_FETCH(gw, paA, pbA, pgA);
    if (gw + NGW < M) POST_FETCH(gw + NGW, paB, pbB, pgB);
    auto process = [&](const int row, u32x4 (&pa)[NP], u32x4 (&pb)[NP], u32x4 (&pg)[NP]) {
        f32x4 v[VPL / 4]; float ss = 0.f; u32x4 cg[NP];
#pragma unroll
        for (int j = 0; j < NP; ++j) { float x0[8], x1[8]; unpack8(pa[j], x0); unpack8(pb[j], x1); cg[j] = pg[j];
            v[2 * j] = (f32x4){x0[0] + x1[0], x0[1] + x1[1], x0[2] + x1[2], x0[3] + x1[3]}; v[2 * j + 1] = (f32x4){x0[4] + x1[4], x0[5] + x1[5], x0[6] + x1[6], x0[7] + x1[7]}; }
        if (row + 2 * NGW < M) POST_FETCH(row + 2 * NGW, pa, pb, pg);
        asm volatile("" ::: "memory");
#pragma unroll
        for (int j = 0; j < VPL / 4; ++j) ss += (v[j].x * v[j].x + v[j].y * v[j].y) + (v[j].z * v[j].z + v[j].w * v[j].w);
#pragma unroll
        for (int o = 1; o < LPH; o <<= 1) ss += shfl_xor_l(ss, o, lane);
        const float rs = 1.0f / sqrtf(ss * (1.f / DVH) + EPS);
        bf16* cp = CAT + (size_t)row * 2048 + cat0 + lane * VPL;
#pragma unroll
        for (int j = 0; j < NP; ++j) { const u32x4 gw4 = cg[j]; const f32x4 n0 = ngr[2 * j], n1 = ngr[2 * j + 1];
            const f32x4 x0 = v[2 * j] * rs * n0, x1 = v[2 * j + 1] * rs * n1;
            float gv[8] = {bflo(gw4.x), bfhi(gw4.x), bflo(gw4.y), bfhi(gw4.y), bflo(gw4.z), bfhi(gw4.z), bflo(gw4.w), bfhi(gw4.w)};
            float r[8];
#pragma unroll
            for (int e = 0; e < 4; ++e) { r[e] = x0[e] * gv[e] * sigmoidf_(gv[e]); r[4 + e] = x1[e] * gv[4 + e] * sigmoidf_(gv[4 + e]); }
            *(u32x4*)(cp + 8 * j) = (u32x4){pk2(r[0], r[1]), pk2(r[2], r[3]), pk2(r[4], r[5]), pk2(r[6], r[7])}; }
    };
    for (int row = gw; row < M; row += 2 * NGW) {
        process(row, paA, pbA, pgA);
        if (row + NGW < M) process(row + NGW, paB, pbB, pgB);
    }
#undef POST_FETCH
}

#ifndef TAIL_CONV
#define TAIL_CONV 0
#endif
#ifndef EARLY_CONV_ODD
#define EARLY_CONV_ODD 1
#endif
constexpr int EVEN_SHARED = 12544;
constexpr int TQ_IE = 64 * 8 * 6, TQ_IO = 80 * 8 * 6, TQ_UP = 104 * 8 * 6;
typedef __attribute__((address_space(1))) unsigned char GU8;
constexpr int PH_PER_LAYER = 9, NPHASES = 1 + 4 * PH_PER_LAYER + 1;
__global__ void __launch_bounds__(NWAVES * 64, 2) fwd_kernel(Args args) {
    extern __shared__ __attribute__((aligned(16))) unsigned char lds_raw[];
    LAS unsigned char* lds = (LAS unsigned char*)lds_raw;
    volatile LAS unsigned* MISC = (volatile LAS unsigned*)(lds + MISC_OFF);
    const int lo = args.ph_lo, hi = args.ph_hi;
    const int wave0 = __builtin_amdgcn_readfirstlane((int)threadIdx.x >> 6);
    for (int u = threadIdx.x; u < (LDS_BYTES - MISC_OFF) / 4; u += NWAVES * 64) MISC[u] = 0u;
    __syncthreads();
    XcdBarrier bar; bar.bar = (unsigned*)(args.ws + WS_CTL) + CW_BAR; bar.x = 0; bar.st = nullptr;
    if (hi - lo > 1) bar = xcd_barrier_post((unsigned*)(args.ws + WS_CTL) + CW_BAR, MISC + 8);
    int ph = 0;
#define PH_ON (ph >= lo && ph < hi)
#define PH_BEGIN GU8* wsg_ = (GU8*)args.ws; asm volatile("" : "+s"(wsg_)); unsigned char* ws = (unsigned char*)wsg_; unsigned mb_ = ~0u; asm volatile("" : "+s"(mb_)); int tid = wave0 * 64 + (int)__builtin_amdgcn_mbcnt_hi(mb_, __builtin_amdgcn_mbcnt_lo(mb_, 0u)); int bid = blockIdx.x; asm volatile("" : "+s"(bid)); int G = gridDim.x; asm volatile("" : "+s"(G)); const int lane = tid & 63, wave = __builtin_amdgcn_readfirstlane(tid >> 6); (void)lane; (void)wave; \
    bf16* X = (bf16*)(ws + WS_X); bf16* H = (bf16*)(ws + WS_H); float* MOD = (float*)(ws + WS_MOD); bf16* PROJ = (bf16*)(ws + WS_PROJ); bf16* CAT = (bf16*)(ws + WS_CAT); (void)X; (void)H; (void)MOD; (void)PROJ; (void)CAT;
#define PH_END do { if (ph + 1 < hi) { XcdBarrier b2 = bar; asm volatile("" : "+s"(b2.bar), "+s"(b2.x)); xcd_barrier(b2); } } while (0)

    if (PH_ON) { PH_BEGIN REP(1) { __syncthreads(); p0_prologue(args, ws, lds, tid, lane, wave, G, bid); } PH_END; } ++ph;

    for (int l = 0; l < 4; ++l) {
        const int li = l >> 1; const bool odd = (l & 1) != 0;
        if (PH_ON) { PH_BEGIN const float* modl = MOD + (size_t)l * 3 * 12288;
            if (l == 0) norm_phase<0, false>(args.in[I_XP], args.in[I_XS], nullptr, args.in[I_N1G] + (size_t)l * D, modl + 0 * D, modl + 1 * D, H, nullptr, lane, wave, G, bid);
            else norm_phase<0, true>(nullptr, nullptr, X, args.in[I_N1G] + (size_t)l * D, modl + 0 * D, modl + 1 * D, H, nullptr, lane, wave, G, bid); PH_END; } ++ph;
        if (PH_ON) { PH_BEGIN
            const int Nn = odd ? ODD_INP : EVEN_IN;
            pg8::Gemm g{H, (const bf16*)(ws + (odd ? WS_WOIN : WS_WEIN)) + (size_t)li * Nn * 2048, M, Nn, D, D, D, 0}; pg8::StaticOrder S; S.init(M, Nn, G, bid);
            pg8::EpiBf16 E{PROJ, Nn, (float*)(ws + WS_Z1), odd ? 24 : -1}; REP(3) pg8::gemm_phase<pg8::EpiBf16, pg8::StaticOrder, true>(lds, g, S, E, tid);
            if (TAIL_CONV && !CONV_IN_PROLOGUE && l < 3) { PH_BEGIN const int nwg_ = (M / 256) * ((odd ? ODD_INP : EVEN_IN) / 256), busy = nwg_ - ((nwg_ + 255) / 256 - 1) * 256;
                if (G == 256 && bid >= busy) { const int lo_ = l == 0 ? 0 : (l == 1 ? 0 : TQ_IO + TQ_UP), n_ = odd ? TQ_IO : TQ_IE;
                    convert_layer(args, ws, (LAS float*)(lds + wave * 16384), l == 0 ? 0 : 2, 2, lo_, lo_ + n_, false, (bid - busy) * NWAVES + wave, (G - busy) * NWAVES, lane, 0, 1); } }
            PH_END; } ++ph;
        if (PH_ON) { PH_BEGIN REP(4) { __syncthreads(); if (!odd) prep_ret(args, ws, lds, li, tid, lane, wave, G, bid); else prep_gla(args, ws, lds, li, tid, lane, wave, G, bid); } PH_END; } ++ph;
        if (PH_ON) { PH_BEGIN
            if (!odd) {
                REP(5) { __syncthreads(); scan_phase<128, 8, 128>(ws, lds, li, args.in[I_SRET], args.out + OUT_SR, args.in[I_RDEC], tid, lane, wave, G, bid); }
                __syncthreads();
                pg8::Gemm g{(const bf16*)(ws + WS_POOLED), (const bf16*)(ws + WS_WPOOL) + (size_t)li * 4 * 65536, M, 1024, 256, 1024, 256, 512};
                pg8::EpiBf16 E{CAT, 2048, nullptr, -1};
                pg8::StaticOrder S; S.init(M, 1024, G, (bid + G - (G >= 256 ? 64 : 0)) % G);
                pg8::gemm_phase<pg8::EpiBf16, pg8::StaticOrder, true>(lds, g, S, E, tid);
            } else {
                if (!CONV_IN_PROLOGUE && EARLY_CONV_ODD && G == 256 && bid >= 128 && (bid & 1)) { PH_BEGIN
                    convert_layer(args, ws, (LAS float*)(lds + wave * 16384), l, 2, 0, 1 << 30, false, (bid - 128) * NWAVES + wave, (G - 128) * NWAVES, lane, (bid - 128) * 512 + tid, (G - 128) * 512);
                    if (l < 3) convert_layer(args, ws, (LAS float*)(lds + wave * 16384), l + 1, 1, 0, 1 << 30, true, (bid - 128) * NWAVES + wave, (G - 128) * NWAVES, lane, (bid - 128) * 512 + tid, (G - 128) * 512); }
                REP(5) { __syncthreads(); scan_phase<256, 4, 512>(ws, lds, li, args.in[I_SGLA], args.out + OUT_SG, nullptr, tid, lane, wave, G, bid); } }
            if (!CONV_IN_PROLOGUE) { PH_BEGIN
                const int nlong = odd ? 128 : 64, nl = G > nlong ? nlong : 0;
                __syncthreads();
                const bool tails = TAIL_CONV && G == 256;
                const int p2lo = !tails ? 0 : (l == 0 ? TQ_IE : (l == 2 ? TQ_IO + TQ_UP + TQ_IE : 0)), p1lo = (tails && !odd) ? TQ_UP : 0;
                const int xs = (!odd && !tails && nl > 0) ? EVEN_SHARED : p2lo;
                if (xs > p2lo) convert_layer(args, ws, (LAS float*)(lds + wave * 16384), l, 2, p2lo, xs, false, bid * NWAVES + wave, G * NWAVES, lane, 0, 1);
                const bool done_early = odd && !tails && EARLY_CONV_ODD && G == 256 && bid >= 128 && (bid & 1);
                if (bid >= nl && !done_early) { convert_layer(args, ws, (LAS float*)(lds + wave * 16384), l, 2, xs, 1 << 30, false, (bid - nl) * NWAVES + wave, (G - nl) * NWAVES, lane, (bid - nl) * 512 + tid, (G - nl) * 512);
                    if (l < 3) convert_layer(args, ws, (LAS float*)(lds + wave * 16384), l + 1, 1, p1lo, 1 << 30, true, (bid - nl) * NWAVES + wave, (G - nl) * NWAVES, lane, (bid - nl) * 512 + tid, (G - nl) * 512); } }
            PH_END; } ++ph;
        if (PH_ON) { PH_BEGIN REP(6) if (!odd) post_phase<1024, 128>(ws, args.in[I_RNG] + (size_t)li * 1024, EVEN_IN, 1024, lane, wave, G, bid); else post_phase<2048, 512>(ws, args.in[I_GNG] + (size_t)li * 2048, ODD_INP, 0, lane, wave, G, bid); PH_END; } ++ph;
        if (PH_ON) { PH_BEGIN const float* modl = MOD + (size_t)l * 3 * 12288;
            pg8::Gemm g{CAT, (const bf16*)(ws + (odd ? WS_WOOUT : WS_WEOUT)) + (size_t)li * 2048 * 2048, M, D, D, D, D, 0};
            pg8::EpiResid E{args.in[I_XP], args.in[I_XS], l == 0, args.dry ? (bf16*)(ws + WS_UP) : X, modl + 2 * D, ws, (LAS unsigned*)(lds + 131072), 2 * l, 2 * l + 8 * args.dry};
            pg8::SplitOrder S; S.init(M, D, G, bid); S.Kh = D / 2; pg8::gemm_phase<pg8::EpiResid, pg8::SplitOrder, true>(lds, g, S, E, tid);
            PH_END; } ++ph;
        if (PH_ON) { PH_BEGIN const float* modl = MOD + (size_t)l * 3 * 12288;
            norm_phase<0, true>(nullptr, nullptr, X, args.in[I_N2G] + (size_t)l * D, modl + 3 * D, modl + 4 * D, H, nullptr, lane, wave, G, bid); PH_END; } ++ph;
        if (PH_ON) { PH_BEGIN
#if PROBE_LAUNCH_DUP == 28
            const int Kup = args.dry ? D / 2 : D;
#else
            constexpr int Kup = D;
#endif
            pg8::Gemm g{H, (const bf16*)(ws + WS_WUP) + (size_t)l * NUP * 2048, 50 * 256, NUP, Kup, D, D, 0}; pg8::UpOrder S; S.init(50 * 256, NUP, G, bid);
            pg8::EpiUpConv E{(bf16*)(ws + WS_ACT), args.in[I_CONVW] + (size_t)l * 3 * FF, args.in[I_CONVB] + (size_t)l * FF, (LAS float*)(lds + 131072)};
            REP(7) pg8::gemm_phase<pg8::EpiUpConv, pg8::UpOrder, true>(lds, g, S, E, tid);
            if (TAIL_CONV && !CONV_IN_PROLOGUE && l < 3) { PH_BEGIN constexpr int nwg_ = 50 * (NUP / 256), busy = nwg_ - ((nwg_ + 255) / 256 - 1) * 256;
                if (G == 256 && bid >= busy) { const int lo_ = odd ? TQ_IO : 0;
                    convert_layer(args, ws, (LAS float*)(lds + wave * 16384), odd ? 2 : l + 1, odd ? 2 : 1, lo_, lo_ + TQ_UP, false, (bid - busy) * NWAVES + wave, (G - busy) * NWAVES, lane, 0, 1); } }
            PH_END; } ++ph;
        if (PH_ON) { PH_BEGIN const float* modl = MOD + (size_t)l * 3 * 12288;
            pg8::Gemm g{(const bf16*)(ws + WS_ACT), (const bf16*)(ws + WS_WDN) + (size_t)l * 2048 * FF, M, D, FF, FF, FF, 0};
            pg8::EpiResid E{nullptr, nullptr, false, args.dry ? (bf16*)(ws + WS_UP) : X, modl + 5 * D, ws, (LAS unsigned*)(lds + 131072), 2 * l + 1, 2 * l + 1 + 8 * args.dry};
            pg8::SplitOrder S; S.init(M, D, G, bid); S.Kh = FF / 2; pg8::gemm_phase<pg8::EpiResid, pg8::SplitOrder, true>(lds, g, S, E, tid);
            PH_END; } ++ph;
    }
    if (PH_ON) { PH_BEGIN norm_phase<1, true>(nullptr, nullptr, X, args.in[I_FING], nullptr, nullptr, nullptr, args.out, lane, wave, G, bid); } ++ph;
#undef PH_ON
#undef PH_BEGIN
#undef PH_END
}

extern "C" void kernel_launch(void* const* d_in, const int* in_sizes, int n_in, void* d_out, int out_size, void* d_ws, size_t ws_size, hipStream_t stream) {
    static int grid = 0;
    if (grid == 0) {
        if (n_in != N_IN || ws_size < WS_END2) { fprintf(stderr, "kernel_launch: expected %d inputs and >= %zu bytes of workspace; got %d, %zu; nothing launched\n", (int)N_IN, (size_t)WS_END2, n_in, ws_size); grid = -1; return; }
        int dev = 0, cus = 0, per_cu = 0;
        if (hipGetDevice(&dev) != hipSuccess || hipDeviceGetAttribute(&cus, hipDeviceAttributeMultiprocessorCount, dev) != hipSuccess) { fprintf(stderr, "kernel_launch: device query failed\n"); grid = -1; return; }
        if (hipFuncSetAttribute((const void*)fwd_kernel, hipFuncAttributeMaxDynamicSharedMemorySize, LDS_BYTES) != hipSuccess) { fprintf(stderr, "kernel_launch: hipFuncSetAttribute failed\n"); grid = -1; return; }
        if (hipOccupancyMaxActiveBlocksPerMultiprocessor(&per_cu, (const void*)fwd_kernel, NWAVES * 64, LDS_BYTES) != hipSuccess || per_cu < 1)
            fprintf(stderr, "kernel_launch: note: occupancy query reports %d workgroups per CU\n", per_cu);
        (void)hipGetLastError();
        grid = cus;
    }
    if (grid < 0) return;
    (void)in_sizes; (void)out_size;
    if (hipMemsetAsync((char*)d_ws + WS_CTL, 0, CTL_ZERO_BYTES, stream) != hipSuccess) { fprintf(stderr, "kernel_launch: memset failed\n"); return; }
    Args a{};
    for (int i = 0; i < N_IN; ++i) a.in[i] = (const float*)d_in[i];
    a.out = (float*)d_out; a.ws = (unsigned char*)d_ws;
#if defined(PROBE_LAUNCH_DUP) && PROBE_LAUNCH_DUP
    for (int p = 0; p < NPHASES; ++p) { a.ph_lo = p; a.ph_hi = p + 1;
        const int cls = p == 0 ? 10 : (p == NPHASES - 1 ? 11 : (p - 1) % PH_PER_LAYER + 1);
        if (cls + 20 == PROBE_LAUNCH_DUP) { a.dry = 1; hipLaunchKernelGGL(fwd_kernel, dim3(grid), dim3(NWAVES * 64), LDS_BYTES, stream, a); a.dry = 0; }
        hipLaunchKernelGGL(fwd_kernel, dim3(grid), dim3(NWAVES * 64), LDS_BYTES, stream, a);
        if (cls == PROBE_LAUNCH_DUP) hipLaunchKernelGGL(fwd_kernel, dim3(grid), dim3(NWAVES * 64), LDS_BYTES, stream, a); }
#elif MK_ONE_LAUNCH
    a.ph_lo = 0; a.ph_hi = NPHASES;
    hipLaunchKernelGGL(fwd_kernel, dim3(grid), dim3(NWAVES * 64), LDS_BYTES, stream, a);
#else
    for (int p = 0; p < NPHASES; ++p) { a.ph_lo = p; a.ph_hi = p + 1; hipLaunchKernelGGL(fwd_kernel, dim3(grid), dim3(NWAVES * 64), LDS_BYTES, stream, a); }
#endif
    const hipError_t le = hipPeekAtLastError();
    if (le != hipSuccess) fprintf(stderr, "kernel_launch: launch failed: %s\n", hipGetErrorName(le));
}
```

```cpp
#include <hip/hip_runtime.h>
#include <cstdio>
#include <cstdint>

#ifndef PROBE_DUP
#define PROBE_DUP 0
#endif
#define REP(k) for (int rep_ = 0; rep_ < ((PROBE_DUP) == (k) ? 2 : 1); ++rep_)
#ifndef CONV_IN_PROLOGUE
#define CONV_IN_PROLOGUE 0
#endif
#ifndef PROBE_LAUNCH_DUP
#define PROBE_LAUNCH_DUP 0
#endif
#ifndef MK_ONE_LAUNCH
#define MK_ONE_LAUNCH 1
#endif

namespace pg8 {
#define PG8_LAS __attribute__((address_space(3)))
typedef unsigned short bf16_t;
typedef short bf16x8 __attribute__((ext_vector_type(8)));
typedef float f32x4 __attribute__((ext_vector_type(4)));
typedef unsigned u32x4 __attribute__((ext_vector_type(4)));
constexpr int BM = 256, BK = 64, HALF = 128, HTB = HALF * BK * 2, STAGE_BYTES = 8 * HTB, NXCD = 8, WGM = 8;

__host__ __device__ __forceinline__ int lds_byte(int r, int c) { const int st = (r >> 4) * 2 + (c >> 5), rr = r & 15, cc = c & 31, ob = rr * 64 + cc * 2; return st * 1024 + (ob ^ (((ob >> 9) & 1) << 5)); }
__host__ __device__ __forceinline__ void stage_rc(int b, int& R, int& C) { const int st = b / 1024, sb = b % 1024, swz = sb ^ (((sb >> 9) & 1) << 5); R = (st >> 1) * 16 + swz / 64; C = (st & 1) * 32 + (swz % 64) / 2; }
__host__ __device__ __forceinline__ int perm32(int rho) { const int n = rho >> 4, i = rho & 15; return 8 * (i >> 2) + 4 * n + (i & 3); }

struct Unit { int pm, pn, k0, nt, sid; };
struct Gemm { const bf16_t* A; const bf16_t* Bt; int M, N, K, lda, ldb, a_pn_bytes; };

struct StaticOrder {
    int nM, nN, nwg, G, c;
    __host__ __device__ void init(int M, int N, int G_, int c_) { nM = M / BM; nN = N / BM; nwg = nM * nN; G = G_; c = c_; }
    __host__ __device__ void map(int L, Unit& u) const {
        int wgid = L; { const int q = nwg / NXCD, r = nwg % NXCD, xcd = wgid % NXCD, off = wgid / NXCD; wgid = (xcd < r ? xcd * (q + 1) : r * (q + 1) + (xcd - r) * q) + off; }
        const int nig = WGM * nN, gid = wgid / nig, fm = gid * WGM, gsz = (nM - fm) < WGM ? (nM - fm) : WGM;
        u.pm = fm + ((wgid % nig) % gsz); u.pn = (wgid % nig) / gsz; u.k0 = 0; u.nt = 0; u.sid = 0;
    }
    __host__ __device__ bool next(int i, Unit& u) const {
        const long L = (long)i * G + c; if (L >= nwg) return false;
        map((int)L, u); return true;
    }
    __device__ __forceinline__ void a_ready(const Unit&) const {}
    __device__ __forceinline__ void done(const Unit&) const {}
    __device__ __forceinline__ int arow(int pm) const { return pm * BM; }
};
struct UpOrder : StaticOrder {
    __device__ __forceinline__ int arow(int pm) const { return pm < 16 ? pm * BM : 4096 + ((pm - 16) / 17) * 4096 + 254 * ((pm - 16) % 17) - 1; }
};
struct SplitOrder : StaticOrder {
    int Kh;
    __device__ bool next(int i, Unit& u) const {
        if (G != 256 || nwg != 384) { const long L = (long)i * G + c; if (L >= nwg) return false; map((int)L, u); return true; }
        if (i == 0) { map(c, u); return true; }
        if (i == 1) { map(G + (c >> 1), u); u.k0 = (c & 1) * Kh; u.nt = Kh / BK; u.sid = c >> 1; return true; }
        return false;
    }
};
struct SingleOrder {
    int unit, nN;
    __device__ bool next(int i, Unit& u) const { if (i != 0 || unit < 0) return false; u.pm = unit / nN; u.pn = unit % nN; u.k0 = 0; u.nt = 0; u.sid = 0; return true; }
    __device__ __forceinline__ void a_ready(const Unit&) const {}
    __device__ __forceinline__ void done(const Unit&) const {}
    __device__ __forceinline__ int arow(int pm) const { return pm * BM; }
};

__device__ __forceinline__ unsigned cvt_pk_bf16(float lo, float hi) { unsigned r; asm volatile("v_cvt_pk_bf16_f32 %0, %1, %2" : "=v"(r) : "v"(lo), "v"(hi)); return r; }

struct EpiBf16 {
    static constexpr bool PERM = true;
    bf16_t* O; int ldc; float* Z; int zpn;
    __device__ __forceinline__ void operator()(f32x4 (&acc)[2][2][4][2], const Unit& u, int wr, int wc, int fr, int fq) const {
        const int row0 = u.pm * BM + wr * 64 + fr;
        if (u.pn == zpn) {
            if (wc == 0) {
#pragma unroll
                for (int ai = 0; ai < 2; ++ai)
#pragma unroll
                    for (int m = 0; m < 4; ++m) { float* zp = Z + (size_t)(row0 + ai * HALF + m * 16) * 32 + 8 * fq; *(f32x4*)zp = acc[ai][0][m][0]; *(f32x4*)(zp + 4) = acc[ai][0][m][1]; }
            }
            return;
        }
        const int col0 = u.pn * BM + wc * 64 + 8 * fq;
#pragma unroll
        for (int ai = 0; ai < 2; ++ai)
#pragma unroll
            for (int m = 0; m < 4; ++m) { bf16_t* rowp = O + (size_t)(row0 + ai * HALF + m * 16) * ldc + col0;
#pragma unroll
                for (int bj = 0; bj < 2; ++bj) { const f32x4 v0 = acc[ai][bj][m][0], v1 = acc[ai][bj][m][1];
                    u32x4 w; w.x = cvt_pk_bf16(v0[0], v0[1]); w.y = cvt_pk_bf16(v0[2], v0[3]); w.z = cvt_pk_bf16(v1[0], v1[1]); w.w = cvt_pk_bf16(v1[2], v1[3]);
                    *(u32x4*)(rowp + bj * 32) = w; } }
    }
};
constexpr int SPLIT_CW = 16384;
constexpr size_t SPLIT_SLAB = (size_t)1119 << 20;
struct EpiResid {
    static constexpr bool PERM = true;
    const float* base_ctx; const float* base_smp; bool base_f32; bf16_t* out; const float* gate;
    unsigned char* wsb; PG8_LAS unsigned* ldsw; int spid; int cspid;
    __device__ __forceinline__ void operator()(f32x4 (&acc)[2][2][4][2], const Unit& u, int wr, int wc, int fr_in, int fq_in) const {
        int fr = fr_in, fq = fq_in; asm volatile("" : "+v"(fr), "+v"(fq));
        if (u.nt != 0) {
            const int wid = wr * 4 + wc, lane = fq * 16 + fr;
            unsigned* cnt = (unsigned*)wsb + SPLIT_CW + (cspid * 128 + u.sid) * 64; unsigned* flag = cnt + 32; unsigned* tmo = (unsigned*)wsb + 8;
            float* slab = (float*)(wsb + SPLIT_SLAB) + (size_t)spid * 128 * 65536;
            if (wid == 0 && lane == 0) *ldsw = __hip_atomic_fetch_add(cnt, 1u, __ATOMIC_RELAXED, __HIP_MEMORY_SCOPE_AGENT);
            asm volatile("s_waitcnt lgkmcnt(0)" ::: "memory"); __builtin_amdgcn_s_barrier(); asm volatile("" ::: "memory");
            const unsigned tk = *ldsw;
            const unsigned soff = (unsigned)u.sid * 262144u + (unsigned)wid * 16384u + (unsigned)lane * 16u;
            if (tk == 0u) {
                const __amdgpu_buffer_rsrc_t rs = __builtin_amdgcn_make_buffer_rsrc((void*)slab, (short)0, 128 * 262144, 0x00020000);
#pragma unroll
                for (int ai = 0; ai < 2; ++ai)
#pragma unroll
                    for (int bj = 0; bj < 2; ++bj)
#pragma unroll
                        for (int m = 0; m < 4; ++m) { const f32x4 v0 = acc[ai][bj][m][0], v1 = acc[ai][bj][m][1];
                            u32x4 w; w.x = cvt_pk_bf16(v0[0], v0[1]); w.y = cvt_pk_bf16(v0[2], v0[3]); w.z = cvt_pk_bf16(v1[0], v1[1]); w.w = cvt_pk_bf16(v1[2], v1[3]);
                            __builtin_amdgcn_raw_buffer_store_b128(w, rs, (int)soff, ((ai * 2 + bj) * 4 + m) * 1024, 16); }
                asm volatile("s_waitcnt vmcnt(0)" ::: "memory");
                if (lane == 0) __hip_atomic_fetch_add(flag, 1u, __ATOMIC_RELAXED, __HIP_MEMORY_SCOPE_AGENT);
                return;
            }
            if (wid == 0) {
                unsigned sp = 0;
                while ((unsigned)__builtin_amdgcn_readfirstlane(__hip_atomic_load(flag, __ATOMIC_RELAXED, __HIP_MEMORY_SCOPE_AGENT)) < 8u) {
                    __builtin_amdgcn_s_sleep(2);
                    if (++sp > (1u << 22)) { if (lane == 0) __hip_atomic_store(tmo, 1u, __ATOMIC_RELAXED, __HIP_MEMORY_SCOPE_AGENT); break; } }
                __builtin_amdgcn_fence(__ATOMIC_ACQUIRE, "agent");
                asm volatile("s_waitcnt vmcnt(0)" ::: "memory");
            }
            asm volatile("" ::: "memory"); __builtin_amdgcn_s_barrier(); asm volatile("" ::: "memory");
            const __amdgpu_buffer_rsrc_t rs = __builtin_amdgcn_make_buffer_rsrc((void*)slab, (short)0, 128 * 262144, 0x00020000);
            finish<true>(acc, u, wr, wc, fr, fq, rs, (int)soff);
            return;
        }
        const __amdgpu_buffer_rsrc_t rs0 = __builtin_amdgcn_make_buffer_rsrc((void*)wsb, (short)0, 16, 0x00020000);
        finish<false>(acc, u, wr, wc, fr, fq, rs0, 0);
    }
    template <bool ADD>
    __device__ __forceinline__ void finish(const f32x4 (&acc)[2][2][4][2], const Unit& u, int wr, int wc, int fr, int fq, const __amdgpu_buffer_rsrc_t rs, int soff) const {
        if (base_f32) finish2<ADD, true>(acc, u, wr, wc, fr, fq, rs, soff); else finish2<ADD, false>(acc, u, wr, wc, fr, fq, rs, soff);
    }
    template <bool ADD, bool F32B>
    __device__ __forceinline__ void finish2(const f32x4 (&acc)[2][2][4][2], const Unit& u, int wr, int wc, int fr, int fq, const __amdgpu_buffer_rsrc_t rs, int soff) const {
        constexpr int MB = F32B ? 2 : 4;
        const int cv = u.pm < 16 ? 0 : 1 + ((u.pm - 16) >> 4);
        const float* bp = u.pm < 16 ? base_ctx + (size_t)u.pm * BM * 2048 : base_smp + (size_t)(u.pm - 16) * BM * 2048;
        const bf16_t* xb = out + (size_t)u.pm * BM * 2048; bf16_t* op = out + (size_t)u.pm * BM * 2048;
        const int col0 = u.pn * BM + wc * 64 + 8 * fq;
        const float* gp = gate + (size_t)cv * 12288 + col0;
        f32x4 gv[2][2];
#pragma unroll
        for (int bj = 0; bj < 2; ++bj)
#pragma unroll
            for (int n = 0; n < 2; ++n) gv[bj][n] = *(const f32x4*)(gp + bj * 32 + 4 * n);
#pragma unroll
        for (int ai = 0; ai < 2; ++ai)
#pragma unroll
            for (int m0 = 0; m0 < 4; m0 += MB) {
                f32x4 fb[MB][2][2]; u32x4 xw[MB][2]; u32x4 sw[MB][2];
#pragma unroll
                for (int mm = 0; mm < MB; ++mm) { const unsigned off = (unsigned)((ai * HALF + wr * 64 + (m0 + mm) * 16 + fr) * 2048 + col0);
#pragma unroll
                    for (int bj = 0; bj < 2; ++bj) {
                        if (F32B) { fb[mm][bj][0] = *(const f32x4*)(bp + off + bj * 32); fb[mm][bj][1] = *(const f32x4*)(bp + off + bj * 32 + 4); }
                        else xw[mm][bj] = *(const u32x4*)(xb + off + bj * 32);
                        if (ADD) sw[mm][bj] = __builtin_amdgcn_raw_buffer_load_b128(rs, soff, ((ai * 2 + bj) * 4 + m0 + mm) * 1024, 0); } }
                __builtin_amdgcn_sched_barrier(0);
#pragma unroll
                for (int mm = 0; mm < MB; ++mm) { const int m = m0 + mm; const unsigned off = (unsigned)((ai * HALF + wr * 64 + m * 16 + fr) * 2048 + col0);
#pragma unroll
                    for (int bj = 0; bj < 2; ++bj) { f32x4 b0, b1;
                        if (F32B) { b0 = fb[mm][bj][0]; b1 = fb[mm][bj][1]; }
                        else { const u32x4 w = xw[mm][bj];
                            b0 = (f32x4){__builtin_bit_cast(float, w.x << 16), __builtin_bit_cast(float, w.x & 0xffff0000u), __builtin_bit_cast(float, w.y << 16), __builtin_bit_cast(float, w.y & 0xffff0000u)};
                            b1 = (f32x4){__builtin_bit_cast(float, w.z << 16), __builtin_bit_cast(float, w.z & 0xffff0000u), __builtin_bit_cast(float, w.w << 16), __builtin_bit_cast(float, w.w & 0xffff0000u)}; }
                        f32x4 v0 = acc[ai][bj][m][0], v1 = acc[ai][bj][m][1];
                        if (ADD) { const u32x4 w = sw[mm][bj];
                            { const unsigned o0 = cvt_pk_bf16(v0[0], v0[1]), o1 = cvt_pk_bf16(v0[2], v0[3]), o2 = cvt_pk_bf16(v1[0], v1[1]), o3 = cvt_pk_bf16(v1[2], v1[3]);
                              v0 = (f32x4){__builtin_bit_cast(float, o0 << 16), __builtin_bit_cast(float, o0 & 0xffff0000u), __builtin_bit_cast(float, o1 << 16), __builtin_bit_cast(float, o1 & 0xffff0000u)};
                              v1 = (f32x4){__builtin_bit_cast(float, o2 << 16), __builtin_bit_cast(float, o2 & 0xffff0000u), __builtin_bit_cast(float, o3 << 16), __builtin_bit_cast(float, o3 & 0xffff0000u)}; }
                            v0 += (f32x4){__builtin_bit_cast(float, w.x << 16), __builtin_bit_cast(float, w.x & 0xffff0000u), __builtin_bit_cast(float, w.y << 16), __builtin_bit_cast(float, w.y & 0xffff0000u)};
                            v1 += (f32x4){__builtin_bit_cast(float, w.z << 16), __builtin_bit_cast(float, w.z & 0xffff0000u), __builtin_bit_cast(float, w.w << 16), __builtin_bit_cast(float, w.w & 0xffff0000u)}; }
                        const f32x4 x0 = b0 + gv[bj][0] * v0, x1 = b1 + gv[bj][1] * v1;
                        u32x4 w; w.x = cvt_pk_bf16(x0[0], x0[1]); w.y = cvt_pk_bf16(x0[2], x0[3]); w.z = cvt_pk_bf16(x1[0], x1[1]); w.w = cvt_pk_bf16(x1[2], x1[3]);
                        *(u32x4*)(op + off + bj * 32) = w; } }
                asm volatile("" ::: "memory"); __builtin_amdgcn_sched_barrier(0); }
    }
};
__device__ __forceinline__ float dpp_ror1(float v) { return __builtin_bit_cast(float, __builtin_amdgcn_update_dpp(0, __builtin_bit_cast(int, v), 0x121, 0xF, 0xF, true)); }
__device__ __forceinline__ float dpp_rol1(float v) { return __builtin_bit_cast(float, __builtin_amdgcn_update_dpp(0, __builtin_bit_cast(int, v), 0x12F, 0xF, 0xF, true)); }
__device__ __forceinline__ float dpp_shr1(float edge, float v) { return __builtin_bit_cast(float, __builtin_amdgcn_update_dpp(__builtin_bit_cast(int, edge), __builtin_bit_cast(int, v), 0x111, 0xF, 0xF, false)); }
__device__ __forceinline__ float dpp_shl1(float edge, float v) { return __builtin_bit_cast(float, __builtin_amdgcn_update_dpp(__builtin_bit_cast(int, edge), __builtin_bit_cast(int, v), 0x101, 0xF, 0xF, false)); }
__device__ __forceinline__ f32x4 shr1v(const f32x4 e, const f32x4 v) { return (f32x4){dpp_shr1(e[0], v[0]), dpp_shr1(e[1], v[1]), dpp_shr1(e[2], v[2]), dpp_shr1(e[3], v[3])}; }
__device__ __forceinline__ f32x4 shl1v(const f32x4 e, const f32x4 v) { return (f32x4){dpp_shl1(e[0], v[0]), dpp_shl1(e[1], v[1]), dpp_shl1(e[2], v[2]), dpp_shl1(e[3], v[3])}; }
__device__ __forceinline__ f32x4 ror1v(const f32x4 v) { return (f32x4){dpp_ror1(v[0]), dpp_ror1(v[1]), dpp_ror1(v[2]), dpp_ror1(v[3])}; }
__device__ __forceinline__ f32x4 rol1v(const f32x4 v) { return (f32x4){dpp_rol1(v[0]), dpp_rol1(v[1]), dpp_rol1(v[2]), dpp_rol1(v[3])}; }
struct EpiUpConv {
    static constexpr bool PERM = true;
    bf16_t* ACT; const float* cw; const float* cb; PG8_LAS float* xb;
    __device__ __forceinline__ void operator()(f32x4 (&acc)[2][2][4][2], const Unit& u, int wr, int wc, int fr, int fq) const {
        constexpr int FFc = 5632;
        const bool ctx = u.pm < 16;
        const int pk = ctx ? 0 : (u.pm - 16) % 17, ps = ctx ? 0 : (u.pm - 16) / 17;
        const int T = ctx ? 256 : 4096, pos0 = ctx ? 0 : 254 * pk - 1;
        const int grow0 = ctx ? u.pm * BM : 4096 + ps * 4096 + pos0;
        const int ch = u.pn * 128 + wc * 32 + 8 * fq;
        f32x4 w0[2], w1[2], w2[2], bb[2];
#pragma unroll
        for (int n = 0; n < 2; ++n) { w0[n] = *(const f32x4*)(cw + ch + 4 * n); w1[n] = *(const f32x4*)(cw + FFc + ch + 4 * n); w2[n] = *(const f32x4*)(cw + 2 * FFc + ch + 4 * n); bb[n] = *(const f32x4*)(cb + ch + 4 * n); }
#pragma unroll
        for (int ai = 0; ai < 2; ++ai)
#pragma unroll
            for (int m = 0; m < 4; ++m) { const int pos = pos0 + ai * HALF + wr * 64 + m * 16 + fr; if ((unsigned)pos >= (unsigned)T) { acc[ai][0][m][0] = (f32x4){0.f, 0.f, 0.f, 0.f}; acc[ai][0][m][1] = (f32x4){0.f, 0.f, 0.f, 0.f}; } }
#pragma unroll
        for (int ai = 0; ai < 2; ++ai) { PG8_LAS float* xp = xb + ((wc * 4 + 2 * ai + wr) * 2) * 32 + 8 * fq;
            if (fr == 0) { *(PG8_LAS f32x4*)xp = acc[ai][0][0][0]; *(PG8_LAS f32x4*)(xp + 4) = acc[ai][0][0][1]; }
            if (fr == 15) { *(PG8_LAS f32x4*)(xp + 32) = acc[ai][0][3][0]; *(PG8_LAS f32x4*)(xp + 36) = acc[ai][0][3][1]; } }
        asm volatile("s_waitcnt lgkmcnt(0)" ::: "memory"); __builtin_amdgcn_s_barrier(); asm volatile("" ::: "memory");
#pragma unroll
        for (int ai = 0; ai < 2; ++ai) {
            const int bI = 2 * ai + wr;
            f32x4 pe[2], ne[2];
#pragma unroll
            for (int n = 0; n < 2; ++n) {
                pe[n] = bI > 0 ? *(const PG8_LAS f32x4*)(xb + ((wc * 4 + bI - 1) * 2 + 1) * 32 + 8 * fq + 4 * n) : (f32x4){0.f, 0.f, 0.f, 0.f};
                ne[n] = bI < 3 ? *(const PG8_LAS f32x4*)(xb + ((wc * 4 + bI + 1) * 2 + 0) * 32 + 8 * fq + 4 * n) : (f32x4){0.f, 0.f, 0.f, 0.f}; }
#pragma unroll
            for (int m = 0; m < 4; ++m) {
                const int tr = ai * HALF + wr * 64 + m * 16 + fr;
                u32x4 w;
#pragma unroll
                for (int n = 0; n < 2; ++n) {
                    const f32x4 cur = acc[ai][0][m][n];
                    const f32x4 rp = m > 0 ? ror1v(acc[ai][0][m > 0 ? m - 1 : 0][n]) : pe[n];
                    const f32x4 ln = m < 3 ? rol1v(acc[ai][0][m < 3 ? m + 1 : 3][n]) : ne[n];
                    const f32x4 prev = shr1v(rp, cur), next = shl1v(ln, cur);
                    const f32x4 av = __builtin_elementwise_fma(next, w2[n], __builtin_elementwise_fma(cur, w1[n], __builtin_elementwise_fma(prev, w0[n], bb[n])));
                    const f32x4 bv = acc[ai][1][m][n];
                    const f32x4 ab = av * bv, ex = av * -1.4426950408889634f;
                    f32x4 o;
#pragma unroll
                    for (int j = 0; j < 4; ++j) o[j] = ab[j] * __builtin_amdgcn_rcpf(1.0f + __builtin_amdgcn_exp2f(ex[j]));
                    if (n == 0) { w.x = cvt_pk_bf16(o[0], o[1]); w.y = cvt_pk_bf16(o[2], o[3]); } else { w.z = cvt_pk_bf16(o[0], o[1]); w.w = cvt_pk_bf16(o[2], o[3]); }
                }
                const bool st = ctx || (tr >= 1 && tr <= 254 && pos0 + tr < T);
                if (st) *(u32x4*)(ACT + (size_t)(grow0 + tr) * FFc + ch) = w;
            }
        }
    }
};

template <class Epi, class Sched, bool ALIGN_EPI>
__device__ __forceinline__ void gemm_phase(PG8_LAS unsigned char* lds, const Gemm g, const Sched& S, const Epi& E, const int tid) {
    const int wid = __builtin_amdgcn_readfirstlane(tid >> 6), lane = tid & 63, wr = wid >> 2, wc = wid & 3, fr = lane & 15, fq = lane >> 4;
    const int K = g.K, nt = K / BK;
    unsigned voffA[2], voffB[2];
#pragma unroll
    for (int i = 0; i < 2; ++i) { int R, C; stage_rc(tid * 16 + i * 8192, R, C); const int Rb = Epi::PERM ? (64 * (R >> 5) + perm32(R & 31)) : R;
        voffA[i] = (unsigned)(R * g.lda + C) * 2u; voffB[i] = (unsigned)(Rb * g.ldb + C) * 2u; }
    const size_t kstep = (size_t)(BK * 2);
    const size_t hstepA = (size_t)HALF * g.lda * 2, hstepB = (size_t)(Epi::PERM ? 32 : HALF) * g.ldb * 2;
    const size_t tstepB = (size_t)BM * g.ldb * 2;
    const unsigned ldsw = (unsigned)wid * 1024u;
    const int aoff = lds_byte(wr * 64 + fr, fq * 8), boff = lds_byte(wc * 32 + fr, fq * 8);
#define PG8_SA(b, h) (((b) * 2 + (h)) * HTB)
#define PG8_SB(b, h) ((4 + (b) * 2 + (h)) * HTB)
#define PG8_STAGE(bufoff, gbase, voff) do { _Pragma("unroll") for (int _i = 0; _i < 2; ++_i) \
        __builtin_amdgcn_global_load_lds((const unsigned*)((const char*)(gbase) + (voff)[_i]), (PG8_LAS unsigned*)(lds + (bufoff) + ldsw + _i * 8192), 16, 0, 0); } while (0)
#define PG8_LDA(dst, b, h) do { _Pragma("unroll") for (int m = 0; m < 4; ++m) _Pragma("unroll") for (int k = 0; k < 2; ++k) dst[m][k] = *(const PG8_LAS bf16x8*)(lds + PG8_SA(b, h) + aoff + m * 2048 + k * 1024); } while (0)
#define PG8_LDB(dst, b, h) do { _Pragma("unroll") for (int n = 0; n < 2; ++n) _Pragma("unroll") for (int k = 0; k < 2; ++k) dst[n][k] = *(const PG8_LAS bf16x8*)(lds + PG8_SB(b, h) + boff + n * 2048 + k * 1024); } while (0)
#define PG8_MMA(ai, bj, At, Bt) do { __builtin_amdgcn_s_setprio(1); _Pragma("unroll") for (int m = 0; m < 4; ++m) _Pragma("unroll") for (int n = 0; n < 2; ++n) _Pragma("unroll") for (int k = 0; k < 2; ++k) \
        acc[ai][bj][m][n] = __builtin_amdgcn_mfma_f32_16x16x32_bf16(Bt[n][k], At[m][k], acc[ai][bj][m][n], 0, 0, 0); __builtin_amdgcn_s_setprio(0); } while (0)
#define PG8_WAIT_V(n) asm volatile("s_waitcnt vmcnt(" #n ")" ::: "memory")
#define PG8_WAIT_L(n) asm volatile("s_waitcnt lgkmcnt(" #n ")" ::: "memory")
#define PG8_BAR __builtin_amdgcn_s_barrier()
#define PG8_SCHED __builtin_amdgcn_sched_barrier(0)
    Unit cur, nxt; int ui = 0;
    if (!S.next(0, cur)) return;
    f32x4 acc[2][2][4][2];
#pragma unroll
    for (int a = 0; a < 2; ++a)
#pragma unroll
        for (int b = 0; b < 2; ++b)
#pragma unroll
            for (int m = 0; m < 4; ++m)
#pragma unroll
                for (int n = 0; n < 2; ++n) acc[a][b][m][n] = (f32x4){0.f, 0.f, 0.f, 0.f};
    bf16x8 At[4][2], B0[2][2], B1[2][2];
    const size_t rowA = (size_t)g.lda * 2;
    const char* cA = (const char*)g.A + (size_t)S.arow(cur.pm) * rowA + (size_t)cur.pn * g.a_pn_bytes + (size_t)cur.k0 * 2; const char* cB = (const char*)g.Bt + (size_t)cur.pn * tstepB + (size_t)cur.k0 * 2;
    int ntc = cur.nt ? cur.nt : nt;
    S.a_ready(cur);
    PG8_STAGE(PG8_SB(0, 0), cB, voffB); PG8_STAGE(PG8_SB(0, 1), cB + hstepB, voffB); PG8_STAGE(PG8_SA(0, 0), cA, voffA); PG8_STAGE(PG8_SA(0, 1), cA + hstepA, voffA);
    if (wr == 1) PG8_BAR;
    PG8_WAIT_V(2); PG8_BAR;
    PG8_STAGE(PG8_SB(1, 0), cB + kstep, voffB); PG8_STAGE(PG8_SA(1, 0), cA + kstep, voffA); PG8_STAGE(PG8_SB(1, 1), cB + hstepB + kstep, voffB);
    PG8_WAIT_V(6); PG8_BAR;
    for (;;) {
        const bool has_next = S.next(ui + 1, nxt);
        const char* nA = has_next ? (const char*)g.A + (size_t)S.arow(nxt.pm) * rowA + (size_t)nxt.pn * g.a_pn_bytes + (size_t)nxt.k0 * 2 : cA; const char* nB = has_next ? (const char*)g.Bt + (size_t)nxt.pn * tstepB + (size_t)nxt.k0 * 2 : cB;
        for (int t = 0; t < ntc; t += 2) {
            const bool last = (t == ntc - 2);
            const char* a1 = cA + (size_t)(t + 1) * kstep;
            const char* a2 = last ? nA : cA + (size_t)(t + 2) * kstep; const char* b2 = last ? nB : cB + (size_t)(t + 2) * kstep;
            const char* a3 = a2 + kstep; const char* b3 = b2 + kstep;
            if (last && has_next) S.a_ready(nxt);
            PG8_LDB(B0, 0, 0); PG8_LDB(B1, 0, 1); PG8_SCHED; PG8_LDA(At, 0, 0); PG8_STAGE(PG8_SA(1, 1), a1 + hstepA, voffA);
            PG8_WAIT_V(8); PG8_WAIT_L(0); PG8_BAR; PG8_MMA(0, 0, At, B0); PG8_MMA(0, 1, At, B1); PG8_BAR; PG8_SCHED;
            PG8_LDA(At, 0, 1); PG8_STAGE(PG8_SB(0, 0), b2, voffB); PG8_STAGE(PG8_SB(0, 1), b2 + hstepB, voffB); PG8_STAGE(PG8_SA(0, 0), a2, voffA);
            PG8_WAIT_V(8); PG8_WAIT_L(0); PG8_BAR; PG8_MMA(1, 0, At, B0); PG8_MMA(1, 1, At, B1); PG8_BAR; PG8_SCHED;
            PG8_LDB(B0, 1, 0); PG8_LDB(B1, 1, 1); PG8_SCHED; PG8_LDA(At, 1, 0); PG8_STAGE(PG8_SA(0, 1), a2 + hstepA, voffA);
            PG8_WAIT_V(8); PG8_WAIT_L(0); PG8_BAR; PG8_MMA(0, 0, At, B0); PG8_MMA(0, 1, At, B1); PG8_BAR; PG8_SCHED;
            PG8_LDA(At, 1, 1); PG8_STAGE(PG8_SB(1, 0), b3, voffB); PG8_STAGE(PG8_SB(1, 1), b3 + hstepB, voffB); PG8_STAGE(PG8_SA(1, 0), a3, voffA);
            PG8_WAIT_V(8); PG8_WAIT_L(0); PG8_BAR; PG8_MMA(1, 0, At, B0); PG8_MMA(1, 1, At, B1); PG8_BAR; PG8_SCHED;
        }
        if constexpr (ALIGN_EPI) { if (wr == 0) PG8_BAR; }
        E(acc, cur, wr, wc, fr, fq); S.done(cur);
        if (!has_next) break;
#pragma unroll
        for (int a = 0; a < 2; ++a)
#pragma unroll
            for (int b = 0; b < 2; ++b)
#pragma unroll
                for (int m = 0; m < 4; ++m)
#pragma unroll
                    for (int n = 0; n < 2; ++n) acc[a][b][m][n] = (f32x4){0.f, 0.f, 0.f, 0.f};
        cur = nxt; cA = nA; cB = nB; ++ui; ntc = cur.nt ? cur.nt : nt;
        if constexpr (ALIGN_EPI) { if (wr == 1) PG8_BAR; }
    }
    PG8_WAIT_V(0);
    if constexpr (!ALIGN_EPI) { if (wr == 0) PG8_BAR; }
    PG8_BAR;
#undef PG8_SA
#undef PG8_SB
#undef PG8_STAGE
#undef PG8_LDA
#undef PG8_LDB
#undef PG8_MMA
#undef PG8_WAIT_V
#undef PG8_WAIT_L
#undef PG8_BAR
#undef PG8_SCHED
}
}

constexpr int NWAVES = 8;
constexpr int D = 2048, M = 12288, NCTX = 4096;
constexpr int FF = 5632, NUP = 11264;
constexpr int EVEN_IN = 5120, ODD_INP = 6400;
constexpr int NCHUNK = 192;
constexpr float EPS = 1e-6f;
constexpr size_t OUT_SR = (size_t)M * D;
constexpr size_t OUT_SG = OUT_SR + (size_t)16 * 2 * 2 * 8 * 128 * 128;

constexpr size_t MiB = 1u << 20;
constexpr size_t WS_CTL = 0, CTL_ZERO_BYTES = 1 * MiB;
constexpr size_t WS_MOD = 1 * MiB;
constexpr size_t WS_WEIN = 2 * MiB;
constexpr size_t WS_WOIN = WS_WEIN + 40 * MiB;
constexpr size_t WS_WEOUT = WS_WOIN + 50 * MiB;
constexpr size_t WS_WOOUT = WS_WEOUT + 16 * MiB;
constexpr size_t WS_WPOOL = WS_WOOUT + 16 * MiB;
constexpr size_t WS_WUP = WS_WPOOL + 1 * MiB;
constexpr size_t WS_WDN = WS_WUP + 176 * MiB;
constexpr size_t WS_X = WS_WDN + 88 * MiB;
constexpr size_t WS_H = WS_X + 96 * MiB;
constexpr size_t WS_T = WS_H + 48 * MiB;
constexpr size_t WS_PROJ = WS_T;
constexpr size_t WS_Z1 = WS_PROJ + 150 * MiB;
constexpr size_t WS_QD = WS_Z1 + 2 * MiB;
constexpr size_t WS_KTT = WS_QD + 48 * MiB;
constexpr size_t WS_AM = WS_KTT + 48 * MiB;
constexpr size_t WS_DEC = WS_AM + 24 * MiB;
constexpr size_t WS_VT = WS_DEC + 2 * MiB;
constexpr size_t WS_POOLED = WS_VT + 48 * MiB;
constexpr size_t WS_O = WS_POOLED + 24 * MiB;
constexpr size_t WS_CAT = WS_O + 192 * MiB;
constexpr size_t WS_T_END1 = WS_CAT + 48 * MiB;
constexpr size_t WS_UP = WS_T;
constexpr size_t WS_ACT = WS_UP + 264 * MiB;
constexpr size_t WS_T_END2 = WS_ACT + 132 * MiB;
constexpr size_t WS_END = WS_T_END1 > WS_T_END2 ? WS_T_END1 : WS_T_END2;
constexpr int CW_BAR = 4096;
constexpr int CW_SPLIT = 16384;
constexpr int CW_TMO = 8;
constexpr size_t WS_SLAB = WS_END;
constexpr size_t WS_END2 = WS_SLAB + 256 * MiB;
static_assert(WS_SLAB == pg8::SPLIT_SLAB && CW_SPLIT == pg8::SPLIT_CW && CW_TMO == 8, "split-unit constants");
static_assert((CW_SPLIT + 16 * 128 * 64) * 4 <= (int)CTL_ZERO_BYTES, "control words inside the per-call memset");

constexpr int LDS_BYTES = 147456;
constexpr int MISC_OFF = 146944;

#define GAS __attribute__((address_space(1)))
#define LAS __attribute__((address_space(3)))
typedef unsigned short bf16;
typedef float f32x4 __attribute__((ext_vector_type(4)));
typedef unsigned u32x4 __attribute__((ext_vector_type(4)));
typedef unsigned u32x2 __attribute__((ext_vector_type(2)));
typedef short bf16x8 __attribute__((ext_vector_type(8)));
typedef short bf16x4 __attribute__((ext_vector_type(4)));
#define LDS_WAIT() asm volatile("s_waitcnt lgkmcnt(0)" ::: "memory")
__device__ __forceinline__ unsigned pk2(float lo, float hi) { unsigned r; asm("v_cvt_pk_bf16_f32 %0, %1, %2" : "=v"(r) : "v"(lo), "v"(hi)); return r; }
__device__ __forceinline__ unsigned f2bf(float f) { return pk2(f, 0.f); }
__device__ __forceinline__ float bf2f(unsigned short b) { return __builtin_bit_cast(float, (unsigned)b << 16); }
__device__ __forceinline__ float bflo(unsigned w) { return __builtin_bit_cast(float, w << 16); }
__device__ __forceinline__ float bfhi(unsigned w) { return __builtin_bit_cast(float, w & 0xffff0000u); }
__device__ __forceinline__ float sigmoidf_(float x) { return 1.f / (1.f + __expf(-x)); }
__device__ __forceinline__ float logsigmoidf_(float x) { return fminf(x, 0.f) - log1pf(__expf(-fabsf(x))); }

#define XB_TMO      128
#define XB_XCNT(j)  (256  + 64 * (j))
#define XB_XSUB(j)  (1280 + 64 * (j))
#define XB_XGEN(j)  (2304 + 64 * (j))
#define XB_TOP      3328
#define XB_TOPGEN   3392
#define XCD_BAR_WORDS 3456
#define XB_SPIN_CAP (1u << 18)

__device__ __forceinline__ unsigned xb_ld(unsigned* p)              { return __hip_atomic_load(p, __ATOMIC_RELAXED, __HIP_MEMORY_SCOPE_AGENT); }
__device__ __forceinline__ unsigned xb_add(unsigned* p, unsigned v) { return __hip_atomic_fetch_add(p, v, __ATOMIC_RELAXED, __HIP_MEMORY_SCOPE_AGENT); }
__device__ __forceinline__ unsigned xb_xcc_id() { return (unsigned)__builtin_amdgcn_s_getreg((3 << 11) | 20) & 0xFu; }
#define XB_SPIN(cond, bar) do { unsigned _sp = 0; while (cond) { __builtin_amdgcn_s_sleep(1); \
    if ((++_sp & 255u) == 0u) { if (xb_ld(&(bar)[XB_TMO])) break; if (_sp > XB_SPIN_CAP) { atomicAdd(&(bar)[XB_TMO], 1u); break; } } } } while (0)

struct XcdBarrier { unsigned* bar; unsigned x; volatile LAS unsigned* st; };

__device__ __forceinline__ XcdBarrier xcd_barrier_post(unsigned* bar, volatile LAS unsigned* st) {
    XcdBarrier b; b.bar = bar; b.x = xb_xcc_id(); b.st = st;
    if (threadIdx.x == 0) (void)xb_add(&bar[XB_XCNT(b.x)], 1u);
    return b;
}
__device__ __forceinline__ void xcd_barrier_complete(unsigned* bar, unsigned x, unsigned& nloc, unsigned& nx) {
    const unsigned G = gridDim.x * gridDim.y * gridDim.z;
    unsigned sum, cnt, mine, sp = 0u;
    for (;;) {
        sum = 0u; cnt = 0u; mine = 0u;
#pragma unroll
        for (unsigned j = 0; j < 16; ++j) { const unsigned c = xb_ld(&bar[XB_XCNT(j)]); sum += c; cnt += (c > 0u) ? 1u : 0u; mine = (j == x) ? c : mine; }
        if (sum == G) break;
        __builtin_amdgcn_s_sleep(1);
        if ((++sp & 255u) == 0u) { if (xb_ld(&bar[XB_TMO])) break; if (sp > XB_SPIN_CAP) { atomicAdd(&bar[XB_TMO], 1u); break; } }
    }
    nloc = mine > 0u ? mine : 1u; nx = cnt > 0u ? cnt : 1u;
}
__device__ __forceinline__ void xcd_barrier(const XcdBarrier& b) {
    asm volatile("s_waitcnt vmcnt(0)" ::: "memory");
    __syncthreads();
    if (threadIdx.x == 0) {
        unsigned* bar = b.bar;
        __builtin_amdgcn_s_waitcnt(0);
        unsigned nloc = b.st[0], nx = b.st[1];
        if (nloc == 0u) { xcd_barrier_complete(bar, b.x, nloc, nx); b.st[0] = nloc; b.st[1] = nx; }
        const unsigned old = xb_add(&bar[XB_XSUB(b.x)], 1u);
        const unsigned gen = old / nloc;
        if (old + 1u == (gen + 1u) * nloc) {
            __builtin_amdgcn_fence(__ATOMIC_RELEASE, "agent");
            asm volatile("s_waitcnt vmcnt(0)" ::: "memory");
            const unsigned og = xb_add(&bar[XB_TOP], 1u);
            const unsigned tg = og / nx;
            if (og + 1u == (tg + 1u) * nx) xb_add(&bar[XB_TOPGEN], 1u);
            else XB_SPIN(xb_ld(&bar[XB_TOPGEN]) == tg, bar);
            __builtin_amdgcn_fence(__ATOMIC_ACQUIRE, "agent");
            xb_add(&bar[XB_XGEN(b.x)], 1u);
            asm volatile("s_waitcnt vmcnt(0)" ::: "memory");
        } else {
            XB_SPIN(xb_ld(&bar[XB_XGEN(b.x)]) == gen, bar);
            __builtin_amdgcn_fence(__ATOMIC_ACQUIRE, "agent");
            asm volatile("s_waitcnt vmcnt(0)" ::: "memory");
        }
    }
    __syncthreads();
}

enum { I_XP = 0, I_XS, I_SRET, I_SGLA, I_C, I_CCTX, I_ADAW, I_ADAB, I_N1G, I_N2G, I_EWIN, I_POOLW, I_POOLS, I_RDEC, I_RNG, I_EWOUT, I_OWIN, I_GW1, I_GW2, I_GB, I_GNG, I_OWOUT, I_WUP, I_CONVW, I_CONVB, I_WDN, I_FING, N_IN };
struct Args { const float* in[N_IN]; float* out; unsigned char* ws; int ph_lo, ph_hi, dry, pad; };

__device__ __forceinline__ float shfl_xor_l(float v, int o, int lane) { return __builtin_bit_cast(float, __builtin_amdgcn_ds_bpermute((lane ^ o) << 2, __builtin_bit_cast(int, v))); }
__device__ __forceinline__ float wave_sum(float v, int lane) {
#pragma unroll
    for (int o = 1; o < 64; o <<= 1) v += shfl_xor_l(v, o, lane);
    return v;
}

struct TrItem { const float* W; bf16* WT; const float* nscale; int ldw, ldk, k0, n0, dn0; };
__device__ __forceinline__ void tr_load(const TrItem& t, int lane, f32x4 (&wv)[8]) {
    const float* wp = t.W + (size_t)(t.k0 + (lane >> 3)) * t.ldw + t.n0 + 4 * (lane & 7);
#pragma unroll
    for (int i = 0; i < 8; ++i) wv[i] = *(const f32x4*)(wp + (size_t)(8 * i) * t.ldw);
}
__device__ __forceinline__ void tr_finish(const TrItem& t, const f32x4 (&wv)[8], LAS float* scr, int lane) {
#pragma unroll
    for (int i = 0; i < 8; ++i)
#pragma unroll
        for (int j = 0; j < 4; ++j) scr[(8 * i + (lane >> 3)) * 33 + 4 * (lane & 7) + j] = wv[i][j];
    LDS_WAIT(); asm volatile("" ::: "memory");
    const int c = lane & 7;
#pragma unroll
    for (int j = 0; j < 4; ++j) { const int n = (lane >> 3) + 8 * j; const LAS float* s = scr + (8 * c) * 33 + n; const float sc = t.nscale ? t.nscale[t.n0 + n] : 1.0f;
        u32x4 o; o.x = pk2(s[0 * 33] * sc, s[1 * 33] * sc); o.y = pk2(s[2 * 33] * sc, s[3 * 33] * sc); o.z = pk2(s[4 * 33] * sc, s[5 * 33] * sc); o.w = pk2(s[6 * 33] * sc, s[7 * 33] * sc);
        *(u32x4*)(t.WT + (size_t)(t.dn0 + n) * t.ldk + t.k0 + 8 * c) = o; }
    LDS_WAIT(); asm volatile("" ::: "memory");
}
__device__ __forceinline__ void convert_layer(const Args& a, unsigned char* ws, LAS float* scr, int l, int parts, int lo, int hi, bool extras, int widx, int nw, int lane, int tidx, int nthreads) {
    constexpr int C_EIN = 32 * 160, C_OIN = 32 * 192, C_OUT = 32 * 64, C_POOL = 4 * 8, C_UP = 32 * 352, C_DN = 88 * 64;
    const int li = l >> 1; const bool odd = (l & 1) != 0;
    const int c_in = (parts & 1) ? (odd ? C_OIN : C_EIN) : 0, c_out = (parts & 2) ? C_OUT : 0, c_pool = ((parts & 1) && !odd) ? 4 * C_POOL : 0, c_up = (parts & 2) ? C_UP : 0, c_dn = (parts & 2) ? C_DN : 0;
    const int ntot = c_in + c_out + c_pool + c_up + c_dn;
    const int nitems = (hi < ntot ? hi : ntot) - lo;
    auto tile_of = [&](int r, int NT, int& kt, int& nt) { constexpr int CBK = 1, CBN = 8 / CBK; const int blk = r >> 3, w = r & 7, nb = NT / CBN; kt = CBK * (blk / nb) + (w / CBN); nt = CBN * (blk % nb) + (w % CBN); };
    auto decode = [&](int r) -> TrItem {
        TrItem t; t.nscale = nullptr; r += lo; int kt, nt;
        if (r < c_in) {
            if (!odd) { tile_of(r, 160, kt, nt); t.W = a.in[I_EWIN] + (size_t)li * 2048 * EVEN_IN; t.ldw = EVEN_IN; t.WT = (bf16*)(ws + WS_WEIN) + (size_t)li * EVEN_IN * 2048; t.ldk = 2048; t.k0 = 64 * kt; t.n0 = 32 * nt; }
            else { tile_of(r, 192, kt, nt); t.W = a.in[I_OWIN] + (size_t)li * 2048 * 6144; t.ldw = 6144; t.WT = (bf16*)(ws + WS_WOIN) + (size_t)li * ODD_INP * 2048; t.ldk = 2048; t.k0 = 64 * kt; t.n0 = 32 * nt; }
            t.dn0 = t.n0; return t; } r -= c_in;
        if (r < c_out) { tile_of(r, 64, kt, nt); t.W = a.in[odd ? I_OWOUT : I_EWOUT] + (size_t)li * 2048 * 2048; t.ldw = 2048; t.WT = (bf16*)(ws + (odd ? WS_WOOUT : WS_WEOUT)) + (size_t)li * 2048 * 2048; t.ldk = 2048; t.k0 = 64 * kt; t.n0 = 32 * nt; t.dn0 = t.n0; return t; } r -= c_out;
        if (r < c_pool) { const int i = li * 4 + r / C_POOL, q = r % C_POOL; t.W = a.in[I_POOLW] + (size_t)i * 256 * 256; t.ldw = 256; t.WT = (bf16*)(ws + WS_WPOOL) + (size_t)i * 256 * 256; t.ldk = 256; t.k0 = 64 * (q / 8); t.n0 = 32 * (q % 8); t.dn0 = t.n0; t.nscale = a.in[I_POOLS] + (size_t)i * 256; return t; } r -= c_pool;
        if (r < c_up) { tile_of(r, 352, kt, nt); const int n0 = 32 * nt, half = n0 >= FF ? 1 : 0, ch0 = n0 - half * FF;
            t.W = a.in[I_WUP] + (size_t)l * 2048 * NUP; t.ldw = NUP; t.WT = (bf16*)(ws + WS_WUP) + (size_t)l * NUP * 2048; t.ldk = 2048; t.k0 = 64 * kt; t.n0 = n0; t.dn0 = 256 * (ch0 >> 7) + 64 * ((ch0 & 127) >> 5) + 32 * half + (ch0 & 31); return t; } r -= c_up;
        tile_of(r, 64, kt, nt); t.W = a.in[I_WDN] + (size_t)l * FF * 2048; t.ldw = 2048; t.WT = (bf16*)(ws + WS_WDN) + (size_t)l * 2048 * FF; t.ldk = FF; t.k0 = 64 * kt; t.n0 = 32 * nt; t.dn0 = t.n0; return t;
    };
    f32x4 w0[8], w1[8], w2[8], w3[8]; TrItem t0, t1, t2, t3;
    const int full4 = (nitems / nw) & ~3;
    if (full4 >= 4) {
        t0 = decode(widx); tr_load(t0, lane, w0); t1 = decode(widx + nw); tr_load(t1, lane, w1); t2 = decode(widx + 2 * nw); tr_load(t2, lane, w2);
        for (int k = 0; k + 4 < full4; k += 4) {
            t3 = decode(widx + (k + 3) * nw); tr_load(t3, lane, w3); tr_finish(t0, w0, scr, lane);
            t0 = decode(widx + (k + 4) * nw); tr_load(t0, lane, w0); tr_finish(t1, w1, scr, lane);
            t1 = decode(widx + (k + 5) * nw); tr_load(t1, lane, w1); tr_finish(t2, w2, scr, lane);
            t2 = decode(widx + (k + 6) * nw); tr_load(t2, lane, w2); tr_finish(t3, w3, scr, lane);
        }
        t3 = decode(widx + (full4 - 1) * nw); tr_load(t3, lane, w3);
        tr_finish(t0, w0, scr, lane); tr_finish(t1, w1, scr, lane); tr_finish(t2, w2, scr, lane); tr_finish(t3, w3, scr, lane);
    }
    { const int r0 = widx + full4 * nw, r1 = r0 + nw, r2 = r1 + nw, r3 = r2 + nw;
      if (r0 < nitems) { t0 = decode(r0); tr_load(t0, lane, w0); }
      if (r1 < nitems) { t1 = decode(r1); tr_load(t1, lane, w1); }
      if (r2 < nitems) { t2 = decode(r2); tr_load(t2, lane, w2); }
      if (r3 < nitems) { t3 = decode(r3); tr_load(t3, lane, w3); }
      if (r0 < nitems) tr_finish(t0, w0, scr, lane);
      if (r1 < nitems) tr_finish(t1, w1, scr, lane);
      if (r2 < nitems) tr_finish(t2, w2, scr, lane);
      if (r3 < nitems) tr_finish(t3, w3, scr, lane); }
    if (extras && odd && (parts & 1)) {
        for (int idx = tidx; idx < 2 * 2048 * 16; idx += nthreads) { const int r = idx & 15, k = (idx >> 4) & 2047, x = idx >> 15;
            ((bf16*)(ws + WS_WOIN))[((size_t)li * ODD_INP + 6144 + x * 16 + r) * 2048 + k] = (bf16)f2bf(a.in[I_GW1][(size_t)li * 2 * 2048 * 16 + idx]); }
        unsigned zu = 0u; asm volatile("" : "+v"(zu));
        for (int idx = tidx; idx < 224 * 2048 / 8; idx += nthreads)
            *(u32x4*)((bf16*)(ws + WS_WOIN) + ((size_t)li * ODD_INP + 6176) * 2048 + (size_t)idx * 8) = (u32x4){zu, zu, zu, zu};
    }
}

__device__ __forceinline__ void p0_prologue(const Args& a, unsigned char* ws, LAS unsigned char* lds, int tid, int lane, int wave, int G, int bid) {
    {
        LAS float* sil = (LAS float*)lds;
        LAS float* red = (LAS float*)(lds + 24576);
        for (int idx = tid; idx < 3 * 2048; idx += 512) { const int cv = idx >> 11, k = idx & 2047; const float v = cv == 0 ? a.in[I_CCTX][k] : a.in[I_C][(cv - 1) * 2048 + k]; sil[idx] = v * sigmoidf_(v); }
        __syncthreads();
        float* MOD = (float*)(ws + WS_MOD);
        const int kq = tid >> 4, c4 = tid & 15;
        for (int it = bid; it < 4 * 192; it += G) {
            const int l = it / 192, n0 = (it % 192) * 64;
            const float* wp = a.in[I_ADAW] + (size_t)l * 2048 * 12288 + n0 + 4 * c4;
            f32x4 a0 = {0.f, 0.f, 0.f, 0.f}, a1 = a0, a2 = a0;
#pragma unroll 8
            for (int k = kq; k < 2048; k += 32) { const f32x4 w = *(const f32x4*)(wp + (size_t)k * 12288); a0 += sil[k] * w; a1 += sil[2048 + k] * w; a2 += sil[4096 + k] * w; }
            *(LAS f32x4*)(red + (kq * 3 + 0) * 64 + 4 * c4) = a0; *(LAS f32x4*)(red + (kq * 3 + 1) * 64 + 4 * c4) = a1; *(LAS f32x4*)(red + (kq * 3 + 2) * 64 + 4 * c4) = a2;
            __syncthreads();
            if (tid < 192) { const int cv = tid >> 6, col = tid & 63; float s = 0.f;
#pragma unroll 8
                for (int q = 0; q < 32; ++q) s += red[(q * 3 + cv) * 64 + col];
                MOD[(size_t)(l * 3 + cv) * 12288 + n0 + col] = s + a.in[I_ADAB][(size_t)l * 12288 + n0 + col]; }
            __syncthreads();
        }
    }
    __syncthreads();
    for (int l = 0; l < (CONV_IN_PROLOGUE ? 4 : 1); ++l) convert_layer(a, ws, (LAS float*)(lds + wave * 16384), l, CONV_IN_PROLOGUE ? 3 : 1, 0, 1 << 30, true, bid * NWAVES + wave, G * NWAVES, lane, bid * 512 + tid, G * 512);
}

__device__ __forceinline__ float fast_logsig(float z) { return -__logf(1.0f + __expf(-z)); }
__device__ __forceinline__ u32x4 pack8(const float (&v)[8]) { return (u32x4){pk2(v[0], v[1]), pk2(v[2], v[3]), pk2(v[4], v[5]), pk2(v[6], v[7])}; }
__device__ __forceinline__ void unpack8(const u32x4 w, float (&v)[8]) { v[0] = bflo(w.x); v[1] = bfhi(w.x); v[2] = bflo(w.y); v[3] = bfhi(w.y); v[4] = bflo(w.z); v[5] = bfhi(w.z); v[6] = bflo(w.w); v[7] = bfhi(w.w); }
template <int MODE, bool XBF>
__device__ __forceinline__ void norm_phase(const float* xc, const float* xs, const bf16* xb, const float* g, const float* sh, const float* sc, bf16* H, float* out, int lane, int wave, int G, int bid) {
    const int gw = bid * NWAVES + wave, NGW = G * NWAVES;
    constexpr int NX = XBF ? 4 : 8;
    u32x4 nxa[NX], nxb[NX], nxc[NX];
#define NORM_FETCH(row_, nx) do { const int r_ = (row_); \
        if (XBF) { _Pragma("unroll") for (int jj = 0; jj < 4; ++jj) nx[jj] = *(const u32x4*)(xb + (size_t)r_ * D + 8 * (lane + 64 * jj)); } \
        else { const float* xr = r_ < NCTX ? xc + (size_t)r_ * D : xs + (size_t)(r_ - NCTX) * D; \
            _Pragma("unroll") for (int jj = 0; jj < 4; ++jj) { nx[2 * jj] = *(const u32x4*)(xr + 8 * (lane + 64 * jj)); nx[2 * jj + 1] = *(const u32x4*)(xr + 8 * (lane + 64 * jj) + 4); } } } while (0)
    if (gw < M) NORM_FETCH(gw, nxa);
    if (gw + NGW < M) NORM_FETCH(gw + NGW, nxb);
    if (gw + 2 * NGW < M) NORM_FETCH(gw + 2 * NGW, nxc);
    f32x4 gs[8], s0[8]; int cvcur = -1;
    auto process = [&](const int row, u32x4 (&nx)[NX]) {
        const int cv = row < NCTX ? 0 : 1 + ((row - NCTX) >> 12);
        f32x4 v[8]; float ss = 0.f;
        if (XBF) {
#pragma unroll
            for (int jj = 0; jj < 4; ++jj) { float t[8]; unpack8(nx[jj], t);
                v[2 * jj] = (f32x4){t[0], t[1], t[2], t[3]}; v[2 * jj + 1] = (f32x4){t[4], t[5], t[6], t[7]}; }
        } else {
#pragma unroll
            for (int j = 0; j < 8; ++j) v[j] = __builtin_bit_cast(f32x4, nx[j]); }
        if (row + 3 * NGW < M) NORM_FETCH(row + 3 * NGW, nx);
        if (cv != cvcur) { cvcur = cv;
#pragma unroll
            for (int jj = 0; jj < 4; ++jj)
#pragma unroll
                for (int e = 0; e < 2; ++e) { const int col = 8 * (lane + 64 * jj) + 4 * e; const f32x4 gg = *(const f32x4*)(g + col);
                    if (MODE == 0) { gs[2 * jj + e] = gg * (1.0f + *(const f32x4*)(sc + (size_t)cv * 12288 + col)); s0[2 * jj + e] = *(const f32x4*)(sh + (size_t)cv * 12288 + col); }
                    else gs[2 * jj + e] = gg; } }
        asm volatile("" ::: "memory");
#pragma unroll
        for (int j = 0; j < 8; ++j) ss += (v[j].x * v[j].x + v[j].y * v[j].y) + (v[j].z * v[j].z + v[j].w * v[j].w);
        const float rstd = 1.0f / sqrtf(wave_sum(ss, lane) * (1.f / D) + EPS);
#pragma unroll
        for (int jj = 0; jj < 4; ++jj) { const int col = 8 * (lane + 64 * jj);
            f32x4 h[2];
#pragma unroll
            for (int e = 0; e < 2; ++e) { if (MODE == 0) h[e] = v[2 * jj + e] * rstd * gs[2 * jj + e] + s0[2 * jj + e]; else h[e] = v[2 * jj + e] * rstd * gs[2 * jj + e]; }
            if (MODE == 0) *(u32x4*)(H + (size_t)row * D + col) = (u32x4){pk2(h[0].x, h[0].y), pk2(h[0].z, h[0].w), pk2(h[1].x, h[1].y), pk2(h[1].z, h[1].w)};
            else { *(f32x4*)(out + (size_t)row * D + col) = h[0]; *(f32x4*)(out + (size_t)row * D + col + 4) = h[1]; } }
    };
    for (int row = gw; row < M; row += 3 * NGW) {
        process(row, nxa);
        if (row + NGW < M) process(row + NGW, nxb);
        if (row + 2 * NGW < M) process(row + 2 * NGW, nxc);
    }
#undef NORM_FETCH
}

__device__ __forceinline__ void tr_store2(const LAS bf16* tile, int cp, int i0, bf16* dst0, bf16* dst1, const float (&sc)[8], int swz = 0) {
    float lo[8], hi[8];
#pragma unroll
    for (int ii = 0; ii < 8; ++ii) { const unsigned w = *(const LAS unsigned*)(tile + (i0 + ii) * 264 + ((((cp >> 2) ^ swz) << 3) + ((2 * cp) & 7))); lo[ii] = bflo(w) * sc[ii]; hi[ii] = bfhi(w) * sc[ii]; }
    *(u32x4*)dst0 = pack8(lo); *(u32x4*)dst1 = pack8(hi);
}

__device__ __forceinline__ void prep_ret(const Args& a, unsigned char* ws, LAS unsigned char* lds, int il, int tid, int lane, int wave, int G, int bid) {
    float zf_ = 0.f; asm volatile("" : "+v"(zf_)); const f32x4 Z4 = {zf_, zf_, zf_, zf_};
    constexpr int PADR = 264;
    LAS bf16* lq = (LAS bf16*)lds; LAS bf16* lk = lq + 64 * PADR; LAS bf16* lv = lk + 64 * PADR; LAS bf16* sAM = lv + 64 * PADR;
    const bf16* PROJ = (const bf16*)(ws + WS_PROJ);
    bf16* QD = (bf16*)(ws + WS_QD); bf16* KTT = (bf16*)(ws + WS_KTT); bf16* AM = (bf16*)(ws + WS_AM); float* DEC = (float*)(ws + WS_DEC); bf16* VT = (bf16*)(ws + WS_VT);
    const int cg = bid & 3;
    const float Lf0 = logsigmoidf_(a.in[I_RDEC][(il * 2 + 0) * 8 + cg * 2]), Lf1 = logsigmoidf_(a.in[I_RDEC][(il * 2 + 0) * 8 + cg * 2 + 1]);
    const float Lb0 = logsigmoidf_(a.in[I_RDEC][(il * 2 + 1) * 8 + cg * 2]), Lb1 = logsigmoidf_(a.in[I_RDEC][(il * 2 + 1) * 8 + cg * 2 + 1]);
#define LF(hh) ((hh) ? Lf1 : Lf0)
#define LB(hh) ((hh) ? Lb1 : Lb0)
    u32x4 q1[2], q2[2], k1[2], k2[2], vv[4];
#define RET_FETCH(it_) do { const int row0_ = ((it_) >> 2) * 64; \
        _Pragma("unroll") for (int j = 0; j < 2; ++j) { const int pp = tid + 512 * j, row = pp >> 4, pq = pp & 15, p = (pq & 3) + 8 * (pq >> 2); \
            const bf16* base = PROJ + (size_t)(row0_ + row) * EVEN_IN + cg * 256 + 8 * p; \
            q1[j] = *(const u32x4*)(base + 1024); q2[j] = *(const u32x4*)(base + 1024 + 32); k1[j] = *(const u32x4*)(base + 2048); k2[j] = *(const u32x4*)(base + 2048 + 32); } \
        _Pragma("unroll") for (int j = 0; j < 4; ++j) { const int p = tid + 512 * j, row = p >> 5, pc = p & 31; vv[j] = *(const u32x4*)(PROJ + (size_t)(row0_ + row) * EVEN_IN + 3072 + cg * 256 + 8 * pc); } } while (0)
    if (bid < 768) RET_FETCH(bid);
    for (int it = bid; it < 768; it += G) {
        const int c = it >> 2, row0 = c * 64; const bool smp = c >= 64; const int cis = smp ? ((c - 64) & 63) : (c & 3);
        __syncthreads();
#pragma unroll
        for (int j = 0; j < 2; ++j) { const int pp = tid + 512 * j, row = pp >> 4, pq = pp & 15, p = (pq & 3) + 8 * (pq >> 2);
            const int d0 = 8 * p, hh = d0 >> 7, ax = (d0 >> 6) & 1, f0 = d0 & 31;
            float x1[8], x2[8], y1[8], y2[8]; unpack8(q1[j], x1); unpack8(q2[j], x2); unpack8(k1[j], y1); unpack8(k2[j], y2);
            if (smp) { const float pos = (float)(ax ? row : cis), a0 = pos * __builtin_amdgcn_exp2f(-(float)f0 * (13.287712379549449f / 32.f));
                constexpr float RI[8] = {1.0f, 0.7498942093324559f, 0.5623413251903491f, 0.4216965034285822f, 0.31622776601683794f, 0.23713737056616552f, 0.1778279410038923f, 0.1333521432163324f};
#pragma unroll
                for (int e = 0; e < 8; ++e) { const float ang = a0 * RI[e]; const float cs = __cosf(ang), sn = __sinf(ang);
                    const float a1 = x1[e] * cs - x2[e] * sn, a2 = x1[e] * sn + x2[e] * cs, b1 = y1[e] * cs - y2[e] * sn, b2 = y1[e] * sn + y2[e] * cs;
                    x1[e] = a1; x2[e] = a2; y1[e] = b1; y2[e] = b2; } }
#pragma unroll
            for (int e = 0; e < 8; ++e) { y1[e] *= 0.08838834764831845f; y2[e] *= 0.08838834764831845f; }
            *(LAS u32x4*)(lq + row * PADR + d0) = pack8(x1); *(LAS u32x4*)(lq + row * PADR + d0 + 32) = pack8(x2);
            *(LAS u32x4*)(lk + row * PADR + d0) = pack8(y1); *(LAS u32x4*)(lk + row * PADR + d0 + 32) = pack8(y2);
            const float ef = __expf(LF(hh) * (float)(row + 1)), eb = __expf(LB(hh) * (float)(64 - row));
            float o1[8], o2[8];
#pragma unroll
            for (int e = 0; e < 8; ++e) { o1[e] = x1[e] * ef; o2[e] = x2[e] * ef; }
            bf16* qf = QD + ((size_t)0 * M + row0 + row) * 1024 + cg * 256 + d0; *(u32x4*)qf = pack8(o1); *(u32x4*)(qf + 32) = pack8(o2);
#pragma unroll
            for (int e = 0; e < 8; ++e) { o1[e] = x1[e] * eb; o2[e] = x2[e] * eb; }
            bf16* qb = QD + ((size_t)1 * M + row0 + row) * 1024 + cg * 256 + d0; *(u32x4*)qb = pack8(o1); *(u32x4*)(qb + 32) = pack8(o2);
            asm volatile("" ::: "memory"); }
#pragma unroll
        for (int j = 0; j < 4; ++j) { int p = tid + 512 * j; asm volatile("" : "+v"(p));
            const int row = p >> 5, pc = p & 31; *(LAS u32x4*)(lv + row * PADR + 8 * (pc ^ ((row >> 3) & 7))) = vv[j]; }
        { const int dp = tid >> 8, d = tid & 255, hh = d >> 7; DEC[((size_t)dp * NCHUNK + c) * 1024 + cg * 256 + d] = __expf(64.f * (dp ? LB(hh) : LF(hh))); }
        if (it + G < 768) RET_FETCH(it + G);
        __syncthreads();
#pragma unroll
        for (int j = 0; j < 4; ++j) { const int t = tid + 512 * j, cp = t & 127, i0 = ((t >> 7) & 7) * 8, dp = t >> 10, hh = cp >> 6;
            float sc[8];
            { const float Lh = dp ? LB(hh) : -LF(hh), ratio = __expf(Lh); sc[0] = __expf(dp ? Lh * (float)i0 : -Lh * (float)(63 - i0));
#pragma unroll
              for (int ii = 1; ii < 8; ++ii) sc[ii] = sc[ii - 1] * ratio; }
            bf16* dst = KTT + (((size_t)dp * NCHUNK + c) * 1024 + cg * 256 + 2 * cp) * 64 + i0; tr_store2(lk, cp, i0, dst, dst + 64, sc); }
        { const float one[8] = {1.f, 1.f, 1.f, 1.f, 1.f, 1.f, 1.f, 1.f};
#pragma unroll
          for (int j = 0; j < 2; ++j) { const int t = tid + 512 * j, i0 = (t & 7) * 8, cp = t >> 3;
              bf16* dst = VT + ((size_t)c * 1024 + cg * 256 + 2 * cp) * 64 + i0; tr_store2(lv, cp, i0, dst, dst + 64, one, (i0 >> 3) & 7); } }
        { const int fr = lane & 15, fq = lane >> 4;
          for (int p = wave; p < 32; p += 8) { const int tj = p & 3, ti = (p >> 2) & 3, hh = p >> 4;
              f32x4 acc = Z4; bf16x8 av[4], bv[4];
#pragma unroll
              for (int ks2 = 0; ks2 < 4; ++ks2) { av[ks2] = *(const LAS bf16x8*)(lq + (16 * ti + fr) * PADR + hh * 128 + 32 * ks2 + 8 * fq); bv[ks2] = *(const LAS bf16x8*)(lk + (16 * tj + fr) * PADR + hh * 128 + 32 * ks2 + 8 * fq); }
              __builtin_amdgcn_sched_barrier(0);
#pragma unroll
              for (int ks2 = 0; ks2 < 4; ++ks2) acc = __builtin_amdgcn_mfma_f32_16x16x32_bf16(av[ks2], bv[ks2], acc, 0, 0, 0);
              __builtin_amdgcn_sched_barrier(0);
#pragma unroll
              for (int r = 0; r < 4; ++r) { const int i = 16 * ti + 4 * fq + r, j = 16 * tj + fr;
                  sAM[((0 * 2 + hh) * 64 + i) * 72 + j] = (unsigned short)f2bf(j <= i ? acc[r] * __expf(LF(hh) * (float)(i - j)) : 0.f);
                  sAM[((1 * 2 + hh) * 64 + i) * 72 + j] = (unsigned short)f2bf(j >= i ? acc[r] * __expf(LB(hh) * (float)(j - i)) : 0.f); } } }
        __syncthreads();
#pragma unroll
        for (int j = 0; j < 4; ++j) { const int row = tid >> 3, pc = tid & 7, dp = j >> 1, hh = j & 1;
            *(u32x4*)(AM + ((((size_t)dp * NCHUNK + c) * 8 + cg * 2 + hh) * 64 + row) * 64 + 8 * pc) = *(const LAS u32x4*)(sAM + (j * 64 + row) * 72 + 8 * pc); }
    }
    for (int it = bid; it < 192; it += G) {
        const int c = it, row0 = c * 64; const bool smp = c >= 64; const int cis = smp ? ((c - 64) & 63) : (c & 3);
        const int T = smp ? 4096 : 256, t0 = cis * 64, srow0 = row0 - t0;
        bf16* POOLED = (bf16*)(ws + WS_POOLED);
        const int cl = tid & 31, ir = tid >> 5;
#pragma unroll
        for (int gi = 0; gi < 4; ++gi) {
            const int win = 2 << gi, hw = win >> 1, IPB = win <= 4 ? 4 : 16 / win;
            const bf16* up = PROJ + (size_t)srow0 * EVEN_IN + 8 * (gi * 32 + cl);
#pragma unroll
            for (int ip0 = 0; ip0 < 4; ip0 += IPB) {
                u32x4 x[16];
#pragma unroll
                for (int q = 0; q < IPB; ++q)
#pragma unroll
                    for (int j = 0; j < win; ++j) { int r = t0 + ir + 16 * (ip0 + q) - hw + j; r = r < 0 ? 0 : (r > T - 1 ? T - 1 : r); x[q * win + j] = *(const u32x4*)(up + (size_t)r * EVEN_IN); }
                asm volatile("" ::: "memory");
#pragma unroll
                for (int q = 0; q < IPB; ++q) {
                    const int i = ir + 16 * (ip0 + q), t = t0 + i;
                    int lo = t - hw; lo = lo < 0 ? 0 : lo; int hi = t + win - hw; hi = hi > T ? T : hi;
                    float s[8] = {0.f, 0.f, 0.f, 0.f, 0.f, 0.f, 0.f, 0.f}, u[8] = {0.f, 0.f, 0.f, 0.f, 0.f, 0.f, 0.f, 0.f};
#pragma unroll
                    for (int j = 0; j < win; ++j) { const int r = t - hw + j; const bool ok = (unsigned)r < (unsigned)T; float v[8]; unpack8(x[q * win + j], v);
#pragma unroll
                        for (int e = 0; e < 8; ++e) { s[e] += ok ? v[e] : 0.f; if (j == hw) u[e] = v[e]; } }
                    const float inv = 1.0f / (float)(hi - lo); float o[8];
#pragma unroll
                    for (int e = 0; e < 8; ++e) o[e] = s[e] * inv - u[e];
                    *(u32x4*)(POOLED + (size_t)(row0 + i) * 1024 + 8 * (gi * 32 + cl)) = pack8(o);
                }
            }
        }
    }
}
#undef LF
#undef RET_FETCH
#undef LB

__device__ __forceinline__ void prep_gla(const Args& a, unsigned char* ws, LAS unsigned char* lds, int jl, int tid, int lane, int wave, int G, int bid) {
    float zf_ = 0.f; asm volatile("" : "+v"(zf_)); const f32x4 Z4 = {zf_, zf_, zf_, zf_};
    constexpr int PADR = 264;
    LAS bf16* lq = (LAS bf16*)lds; LAS bf16* lk = lq + 64 * PADR; LAS bf16* lv = lk + 64 * PADR; LAS bf16* sAM = lv + 64 * PADR;
    LAS float* zl = (LAS float*)(sAM + 64 * 72); LAS float* tot = zl + 64 * 32;
    const bf16* PROJ = (const bf16*)(ws + WS_PROJ);
    bf16* QD = (bf16*)(ws + WS_QD); bf16* KTT = (bf16*)(ws + WS_KTT); bf16* AM = (bf16*)(ws + WS_AM); float* DEC = (float*)(ws + WS_DEC); bf16* VT = (bf16*)(ws + WS_VT);
    const int th = tid >> 8, d = tid & 255;
    const int cg = (bid >> 1) & 3, dir = bid & 1, col = cg * 256 + d;
    float gw2[16];
#pragma unroll
    for (int r = 0; r < 16; ++r) gw2[r] = a.in[I_GW2][((size_t)(jl * 2 + dir) * 16 + r) * 1024 + col];
    const float gbv = a.in[I_GB][(size_t)(jl * 2 + dir) * 1024 + col];
    typedef float f32x2 __attribute__((ext_vector_type(2)));
    f32x2 g2[8]; const float gbs = gbv * -1.4426950408889634f;
#pragma unroll
    for (int r = 0; r < 8; ++r) g2[r] = (f32x2){gw2[2 * r] * -1.4426950408889634f, gw2[2 * r + 1] * -1.4426950408889634f};
    u32x4 qv[4], kv[4], vv[4]; f32x4 zv;
#define GLA_FETCH(it_) do { const int row0_ = ((it_) >> 3) * 64; \
        _Pragma("unroll") for (int j = 0; j < 4; ++j) { const int p = tid + 512 * j, row = p >> 5, pc = p & 31; const bf16* base = PROJ + (size_t)(row0_ + row) * ODD_INP + 8 * pc; \
            qv[j] = *(const u32x4*)(base + cg * 256); kv[j] = *(const u32x4*)(base + 1024 + cg * 256); vv[j] = *(const u32x4*)(base + 2048 + cg * 512 + dir * 256); } \
        zv = *(const f32x4*)((const float*)(ws + WS_Z1) + (size_t)row0_ * 32 + 4 * tid); } while (0)
    if (bid < 1536) GLA_FETCH(bid);
    for (int it = bid; it < 1536; it += G) {
        const int c = it >> 3, row0 = c * 64;
        __syncthreads();
#pragma unroll
        for (int j = 0; j < 4; ++j) { const int p = tid + 512 * j, row = p >> 5, pc = p & 31;
            *(LAS u32x4*)(lq + row * PADR + 8 * pc) = qv[j]; *(LAS u32x4*)(lk + row * PADR + 8 * pc) = kv[j]; *(LAS u32x4*)(lv + row * PADR + 8 * (pc ^ ((row >> 3) & 7))) = vv[j]; }
        *(LAS f32x4*)(zl + 4 * tid) = zv;
        if (it + G < 1536) GLA_FETCH(it + G);
        __syncthreads();
        float lg[32]; float Tsum = 0.f;
#pragma unroll
        for (int i4 = 0; i4 < 32; i4 += 2) { f32x4 zz[2][4];
#pragma unroll
            for (int t4 = 0; t4 < 2; ++t4) { const LAS f32x4* zp = (const LAS f32x4*)(zl + (32 * th + i4 + t4) * 32 + dir * 16);
#pragma unroll
                for (int r4 = 0; r4 < 4; ++r4) zz[t4][r4] = zp[r4]; }
            __builtin_amdgcn_sched_barrier(0);
#pragma unroll
            for (int t4 = 0; t4 < 2; ++t4) { const int ii = i4 + t4; f32x2 za = {gbs, 0.f};
#pragma unroll
                for (int r4 = 0; r4 < 4; ++r4) { za = __builtin_elementwise_fma((f32x2){zz[t4][r4].x, zz[t4][r4].y}, g2[2 * r4], za); za = __builtin_elementwise_fma((f32x2){zz[t4][r4].z, zz[t4][r4].w}, g2[2 * r4 + 1], za); }
                lg[ii] = __builtin_amdgcn_logf(1.0f + __builtin_amdgcn_exp2f(za.x + za.y)) * (-1.f / 16.f); Tsum += lg[ii]; }
            __builtin_amdgcn_sched_barrier(0); }
        tot[th * 256 + d] = Tsum;
        __syncthreads();
        const float T0 = tot[d], Gt = T0 + tot[256 + d];
        float P = th ? T0 : 0.f;
#pragma unroll
        for (int g8 = 0; g8 < 4; ++g8) { float ktv[8];
            unsigned short qs[8], ks[8];
#pragma unroll
            for (int e = 0; e < 8; ++e) { const int i = 32 * th + 8 * g8 + e; qs[e] = lq[i * PADR + d]; ks[e] = lk[i * PADR + d]; }
            __builtin_amdgcn_sched_barrier(0);
#pragma unroll
            for (int e = 0; e < 8; ++e) { const int ii = 8 * g8 + e, i = 32 * th + ii; P += lg[ii]; const float Gi = dir ? (Gt - P + lg[ii]) : P;
                const float q = bf2f(qs[e]), k = bf2f(ks[e]);
                lq[i * PADR + d] = (unsigned short)f2bf(q * 0.0625f * __builtin_amdgcn_exp2f(Gi)); lk[i * PADR + d] = (unsigned short)f2bf(k * __builtin_amdgcn_exp2f(-Gi)); ktv[e] = k * __builtin_amdgcn_exp2f(Gt - Gi); }
            __builtin_amdgcn_sched_barrier(0);
            *(u32x4*)(KTT + (((size_t)dir * NCHUNK + c) * 1024 + col) * 64 + 32 * th + 8 * g8) = pack8(ktv); }
        if (th == 0) DEC[((size_t)dir * NCHUNK + c) * 1024 + col] = __builtin_amdgcn_exp2f(Gt);
        __syncthreads();
#pragma unroll
        for (int j = 0; j < 4; ++j) { const int p = tid + 512 * j, row = p >> 5, pc = p & 31;
            *(u32x4*)(QD + ((size_t)dir * M + row0 + row) * 1024 + cg * 256 + 8 * pc) = *(const LAS u32x4*)(lq + row * PADR + 8 * pc); }
        { const float one[8] = {1.f, 1.f, 1.f, 1.f, 1.f, 1.f, 1.f, 1.f};
#pragma unroll
          for (int j = 0; j < 2; ++j) { const int t = tid + 512 * j, i0 = (t & 7) * 8, cp = t >> 3;
              bf16* dst = VT + ((size_t)c * 2048 + cg * 512 + dir * 256 + 2 * cp) * 64 + i0; tr_store2(lv, cp, i0, dst, dst + 64, one, (i0 >> 3) & 7); } }
        { const int fr = lane & 15, fq = lane >> 4;
#pragma unroll
          for (int j2 = 0; j2 < 2; ++j2) { const int p = wave + 8 * j2, tj = p & 3, ti = p >> 2;
              f32x4 acc = Z4; bf16x8 av[8], bv[8];
#pragma unroll
              for (int ks2 = 0; ks2 < 8; ++ks2) { av[ks2] = *(const LAS bf16x8*)(lq + (16 * ti + fr) * PADR + 32 * ks2 + 8 * fq); bv[ks2] = *(const LAS bf16x8*)(lk + (16 * tj + fr) * PADR + 32 * ks2 + 8 * fq); }
              __builtin_amdgcn_sched_barrier(0);
#pragma unroll
              for (int ks2 = 0; ks2 < 8; ++ks2) acc = __builtin_amdgcn_mfma_f32_16x16x32_bf16(av[ks2], bv[ks2], acc, 0, 0, 0);
              __builtin_amdgcn_sched_barrier(0);
#pragma unroll
              for (int r = 0; r < 4; ++r) { const int i = 16 * ti + 4 * fq + r, j = 16 * tj + fr; const bool keep = dir ? (j >= i) : (j <= i);
                  sAM[i * 72 + j] = (unsigned short)f2bf(keep ? acc[r] : 0.f); } } }
        __syncthreads();
        { const int row = tid >> 3, pc = tid & 7;
          *(u32x4*)(AM + ((((size_t)dir * NCHUNK + c) * 8 + cg) * 64 + row) * 64 + 8 * pc) = *(const LAS u32x4*)(sAM + row * 72 + 8 * pc); }
    }
#undef GLA_FETCH
}

__device__ __forceinline__ unsigned cvt_pk_nv(float lo, float hi) { unsigned r; asm("v_cvt_pk_bf16_f32 %0, %1, %2" : "=v"(r) : "v"(lo), "v"(hi)); return r; }
template <int DK, int NH, int DVH>
__device__ __forceinline__ void scan_phase(unsigned char* ws, LAS unsigned char* lds, int li, const float* state_in, float* state_out, int tid, int lane, int wave, int G, int bid) {
    constexpr int NSL = DVH / 64, NT2 = DK / 32, NVT = NH * DVH, QS = DK + 16, KS = 80, AS = 80, HK = DK / 2;
    constexpr int KB_ = DK <= 128 ? 2 : 4, TB_ = 4;
    constexpr int NPQ = DK / 64, NPK = DK / 64;
    LAS bf16* sQ = (LAS bf16*)lds; LAS bf16* sK = sQ + 64 * QS; LAS bf16* sA = sK + DK * KS; LAS bf16* sV = sA + 64 * AS; LAS float* sD = (LAS float*)(sV + 64 * KS); LAS f32x4* sO = (LAS f32x4*)(sD + DK); LAS bf16* sOut = (LAS bf16*)(sO + 8 * 2 * 64);
    const bf16* QD = (const bf16*)(ws + WS_QD); const bf16* KTT = (const bf16*)(ws + WS_KTT); const bf16* AM = (const bf16*)(ws + WS_AM); const float* DEC = (const float*)(ws + WS_DEC); const bf16* VT = (const bf16*)(ws + WS_VT);
    bf16* O = (bf16*)(ws + WS_O);
    constexpr int n_long = 2 * NH * 2 * NSL, n_short = 16 * NH * 2 * NSL;
    const int fr = lane & 15, fq = lane >> 4, wv = wave & 3, wk = wave >> 2;
    float zf_ = 0.f; asm volatile("" : "+v"(zf_)); const f32x4 Z4 = {zf_, zf_, zf_, zf_};
    int oq[NPQ], lq_[NPQ];
#pragma unroll
    for (int j = 0; j < NPQ; ++j) { const int p = tid + 512 * j, row = p / (DK / 8), pc = p % (DK / 8); oq[j] = row * 1024 + 8 * pc;
        lq_[j] = row * QS + 32 * (pc >> 2) + ((pc & 3) < 2 ? 16 * (pc & 3) : 16 * ((pc & 3) - 2) + 4); }
    const int ok0 = tid * 8, lk0 = (tid >> 3) * KS + 8 * (tid & 7);
    const bool split = (G > n_long) && (G % 8 == 0);
    int q = bid, qstep = G, qend = n_long + n_short;
    if (split) { if (bid < n_long) { qend = n_long; } else { q = n_long + (bid - n_long); qstep = G - n_long; } }
    for (; q < qend; q += qstep) {
        const bool is_long = q < n_long; const int idx = is_long ? q : q - n_long;
        const int x8 = idx & 7, j8 = idx >> 3, sl = j8 % NSL, combo = x8 + 8 * (j8 / NSL);
        const int dir = combo & 1, head = (combo >> 1) % NH, sb = combo / (2 * NH);
        const int cbase = is_long ? 64 + sb * 64 : 4 * sb, nch = is_long ? 64 : 4;
        const int ecol0 = sl * 64 + 16 * wv + fr;
        f32x4 S[NT2];
        const unsigned sob = (unsigned)((wk * HK + 4 * fq) * DVH + ecol0);
        if (is_long) { const float* sp = state_in + ((((size_t)sb * 2 + li) * 2 + dir) * NH + head) * DK * DVH;
            unsigned sob1 = sob; asm volatile("" : "+v"(sob1));
#pragma unroll
            for (int t = 0; t < NT2; ++t)
#pragma unroll
                for (int r = 0; r < 4; ++r) S[t][r] = sp[sob1 + (unsigned)((16 * t + r) * DVH)]; }
        else {
#pragma unroll
            for (int t = 0; t < NT2; ++t) S[t] = Z4; }
        struct Pf { u32x4 q[NPQ], k[NPK], a, v; f32x4 d; } pfA, pfB;
#define SCAN_FETCH(c_, P) do { \
            const bf16* qb_ = QD + ((size_t)dir * M + (size_t)(c_) * 64) * 1024 + head * DK; \
            const bf16* kb_ = KTT + (((size_t)dir * NCHUNK + (c_)) * 1024 + head * DK) * 64; \
            const bf16* ab_ = AM + (((size_t)dir * NCHUNK + (c_)) * 8 + head) * 4096; \
            const bf16* vb_ = VT + ((size_t)(c_) * NVT + head * DVH + sl * 64) * 64; \
            _Pragma("unroll") for (int j = 0; j < NPQ; ++j) P.q[j] = *(const u32x4*)(qb_ + oq[j]); \
            _Pragma("unroll") for (int j = 0; j < NPK; ++j) P.k[j] = *(const u32x4*)(kb_ + ok0 + 4096 * j); \
            P.a = *(const u32x4*)(ab_ + ok0); \
            P.v = *(const u32x4*)(vb_ + ok0); \
            if (tid < DK / 4) P.d = *(const f32x4*)(DEC + ((size_t)dir * NCHUNK + (c_)) * 1024 + head * DK + 4 * tid); } while (0)
#define SCAN_TO_LDS(P) do { \
            _Pragma("unroll") for (int j = 0; j < NPQ; ++j) { *(LAS u32x2*)(sQ + lq_[j]) = (u32x2){P.q[j].x, P.q[j].y}; *(LAS u32x2*)(sQ + lq_[j] + 8) = (u32x2){P.q[j].z, P.q[j].w}; } \
            _Pragma("unroll") for (int j = 0; j < NPK; ++j) *(LAS u32x4*)(sK + lk0 + 64 * KS * j) = P.k[j]; \
            *(LAS u32x4*)(sA + lk0) = P.a; \
            *(LAS u32x4*)(sV + lk0) = P.v; \
            if (tid < DK / 4) *(LAS f32x4*)(sD + 4 * tid) = P.d; } while (0)
#define SCAN_CHUNK(s_) (cbase + (dir ? nch - 1 - (s_) : (s_)))
#define SCAN_STEP(s_, AHEAD, PN2, PN1) do { \
            const int row0 = SCAN_CHUNK(s_) * 64; \
            if ((AHEAD) == 2 && (s_) + 2 < nch) SCAN_FETCH(SCAN_CHUNK((s_) + 2), PN2); \
            f32x4 oacc[4]; \
            _Pragma("unroll") for (int t = 0; t < 4; ++t) oacc[t] = Z4; \
              \
              \
            static_assert(KB_ == DK / 64 && (NT2 == TB_ || NT2 == 2 * TB_), "one o_inter batch, one or two state batches"); \
            bf16x8 afr[KB_][4], vb[2], afA[4]; \
            _Pragma("unroll") for (int k = 0; k < KB_; ++k) _Pragma("unroll") for (int it = 0; it < 4; ++it) \
                afr[k][it] = *(const LAS bf16x8*)(sQ + (16 * it + fr) * QS + wk * HK + 32 * k + 8 * fq); \
            _Pragma("unroll") for (int kk = 0; kk < 2; ++kk) vb[kk] = *(const LAS bf16x8*)(sV + (16 * wv + fr) * KS + 32 * kk + 8 * fq); \
            _Pragma("unroll") for (int it = 0; it < 4; ++it) afA[it] = *(const LAS bf16x8*)(sA + (16 * it + fr) * AS + 32 * wk + 8 * fq); \
            __builtin_amdgcn_sched_barrier(0); \
              \
            _Pragma("unroll") for (int k = 0; k < KB_; ++k) { \
                const f32x4 s0 = S[2 * k], s1 = S[2 * k + 1]; \
                u32x4 bw; bw.x = cvt_pk_nv(s0[0], s0[1]); bw.y = cvt_pk_nv(s0[2], s0[3]); bw.z = cvt_pk_nv(s1[0], s1[1]); bw.w = cvt_pk_nv(s1[2], s1[3]); \
                const bf16x8 bfrag = __builtin_bit_cast(bf16x8, bw); \
                _Pragma("unroll") for (int it = 0; it < 4; ++it) oacc[it] = __builtin_amdgcn_mfma_f32_16x16x32_bf16(afr[k][it], bfrag, oacc[it], 0, 0, 0); } \
            __builtin_amdgcn_sched_barrier(0); \
            f32x4 dvA[TB_], dvB[TB_]; bf16x8 akA[TB_][2], akB[TB_][2]; \
            _Pragma("unroll") for (int k = 0; k < TB_; ++k) { dvA[k] = *(const LAS f32x4*)(sD + wk * HK + 16 * k + 4 * fq); \
                _Pragma("unroll") for (int kk = 0; kk < 2; ++kk) akA[k][kk] = *(const LAS bf16x8*)(sK + (wk * HK + 16 * k + fr) * KS + 32 * kk + 8 * fq); } \
            __builtin_amdgcn_sched_barrier(0); \
              \
            _Pragma("unroll") for (int it = 0; it < 4; ++it) oacc[it] = __builtin_amdgcn_mfma_f32_16x16x32_bf16(afA[it], wk ? vb[1] : vb[0], oacc[it], 0, 0, 0); \
            __builtin_amdgcn_sched_barrier(0); \
              \
            _Pragma("unroll") for (int itl = 0; itl < 2; ++itl) sO[(wave * 2 + itl) * 64 + lane] = wk ? oacc[itl] : oacc[2 + itl]; \
            __builtin_amdgcn_sched_barrier(0); \
              \
            { f32x4 a0[TB_]; \
              _Pragma("unroll") for (int k = 0; k < TB_; ++k) a0[k] = __builtin_amdgcn_mfma_f32_16x16x32_bf16(akA[k][0], vb[0], S[k] * dvA[k], 0, 0, 0); \
              _Pragma("unroll") for (int k = 0; k < TB_; ++k) S[k] = __builtin_amdgcn_mfma_f32_16x16x32_bf16(akA[k][1], vb[1], a0[k], 0, 0, 0); } \
            __builtin_amdgcn_sched_barrier(0); \
            if (NT2 > TB_) { f32x4 a0[TB_];                        \
              _Pragma("unroll") for (int k = 0; k < TB_; ++k) { dvB[k] = *(const LAS f32x4*)(sD + wk * HK + 16 * (TB_ + k) + 4 * fq); \
                  _Pragma("unroll") for (int kk = 0; kk < 2; ++kk) akB[k][kk] = *(const LAS bf16x8*)(sK + (wk * HK + 16 * (TB_ + k) + fr) * KS + 32 * kk + 8 * fq); } \
              __builtin_amdgcn_sched_barrier(0); \
              _Pragma("unroll") for (int k = 0; k < TB_; ++k) a0[k] = __builtin_amdgcn_mfma_f32_16x16x32_bf16(akB[k][0], vb[0], S[TB_ + k] * dvB[k], 0, 0, 0); \
              _Pragma("unroll") for (int k = 0; k < TB_; ++k) S[TB_ + k] = __builtin_amdgcn_mfma_f32_16x16x32_bf16(akB[k][1], vb[1], a0[k], 0, 0, 0); \
              __builtin_amdgcn_sched_barrier(0); } \
            __syncthreads();                                         \
            if ((s_) + 1 < nch) SCAN_TO_LDS(PN1); \
            if ((AHEAD) == 1 && (s_) + 2 < nch) SCAN_FETCH(SCAN_CHUNK((s_) + 2), PN1);     \
            _Pragma("unroll") for (int itl = 0; itl < 2; ++itl) { const f32x4 mine = wk ? oacc[2 + itl] : oacc[itl]; const f32x4 o = mine + sO[((wave ^ 4) * 2 + itl) * 64 + lane]; \
                _Pragma("unroll") for (int r = 0; r < 4; ++r) sOut[(32 * wk + 16 * itl + 4 * fq + r) * AS + 16 * wv + fr] = (unsigned short)f2bf(o[r]); } \
            __syncthreads();                                         \
            *(u32x4*)(O + ((size_t)dir * M + row0 + (tid >> 3)) * 2048 + head * DVH + sl * 64 + 8 * (tid & 7)) = *(const LAS u32x4*)(sOut + (tid >> 3) * AS + 8 * (tid & 7)); \
        } while (0)
        __syncthreads();
        SCAN_FETCH(SCAN_CHUNK(0), pfA); SCAN_TO_LDS(pfA);
        if constexpr (DK <= 128) {
            if (nch > 1) SCAN_FETCH(SCAN_CHUNK(1), pfB);
            __syncthreads();
            for (int s = 0; s < nch; s += 2) {
                SCAN_STEP(s, 2, pfA, pfB);
                SCAN_STEP(s + 1, 2, pfB, pfA);
            }
        } else {
            if (nch > 1) SCAN_FETCH(SCAN_CHUNK(1), pfA);
            __syncthreads();
            for (int s = 0; s < nch; ++s) SCAN_STEP(s, 1, pfA, pfA);
        }
#undef SCAN_STEP
#undef SCAN_CHUNK
#undef SCAN_FETCH
#undef SCAN_TO_LDS
        if (!is_long) { float* sp = state_out + ((((size_t)sb * 2 + li) * 2 + dir) * NH + head) * DK * DVH;
            unsigned sob2 = sob; asm volatile("" : "+v"(sob2));
#pragma unroll
            for (int t = 0; t < NT2; ++t)
#pragma unroll
                for (int r = 0; r < 4; ++r) sp[sob2 + (unsigned)((16 * t + r) * DVH)] = S[t][r]; }
    }
}

template <int NV, int DVH>
__device__ __forceinline__ void post_phase(unsigned char* ws, const float* ng, int ldp, int cat0, int lane, int wave, int G, int bid) {
    const bf16* O = (const bf16*)(ws + WS_O); const bf16* PROJ = (const bf16*)(ws + WS_PROJ); bf16* CAT = (bf16*)(ws + WS_CAT);
    constexpr int VPL = NV / 64, LPH = DVH / VPL, NP = VPL / 8;
    const int gw = bid * NWAVES + wave, NGW = G * NWAVES;
    f32x4 ngr[VPL / 4];
#pragma unroll
    for (int j = 0; j < VPL / 4; ++j) ngr[j] = *(const f32x4*)(ng + lane * VPL + 4 * j);
    u32x4 paA[NP], pbA[NP], pgA[NP], paB[NP], pbB[NP], pgB[NP];
#define POST_FETCH(row_, pa, pb, pg) do { const int r_ = (row_); const bf16* o0 = O + (size_t)r_ * 2048 + lane * VPL; const bf16* o1 = o0 + (size_t)M * 2048; const bf16* gp = PROJ + (size_t)r_ * ldp + 4096 + lane * VPL; \
        _Pragma("unroll") for (int j = 0; j < NP; ++j) { pa[j] = *(const u32x4*)(o0 + 8 * j); pb[j] = *(const u32x4*)(o1 + 8 * j); pg[j] = *(const u32x4*)(gp + 8 * j); } } while (0)
    if (gw < M) POST_FETCH(gw, paA, pbA, pgA);
    if (gw + NGW < M) POST_FETCH(gw + NGW, paB, pbB, pgB);
    auto process = [&](const int row, u32x4 (&pa)[NP], u32x4 (&pb)[NP], u32x4 (&pg)[NP]) {
        f32x4 v[VPL / 4]; float ss = 0.f; u32x4 cg[NP];
#pragma unroll
        for (int j = 0; j < NP; ++j) { float x0[8], x1[8]; unpack8(pa[j], x0); unpack8(pb[j], x1); cg[j] = pg[j];
            v[2 * j] = (f32x4){x0[0] + x1[0], x0[1] + x1[1], x0[2] + x1[2], x0[3] + x1[3]}; v[2 * j + 1] = (f32x4){x0[4] + x1[4], x0[5] + x1[5], x0[6] + x1[6], x0[7] + x1[7]}; }
        if (row + 2 * NGW < M) POST_FETCH(row + 2 * NGW, pa, pb, pg);
        asm volatile("" ::: "memory");
#pragma unroll
        for (int j = 0; j < VPL / 4; ++j) ss += (v[j].x * v[j].x + v[j].y * v[j].y) + (v[j].z * v[j].z + v[j].w * v[j].w);
#pragma unroll
        for (int o = 1; o < LPH; o <<= 1) ss += shfl_xor_l(ss, o, lane);
        const float rs = 1.0f / sqrtf(ss * (1.f / DVH) + EPS);
        bf16* cp = CAT + (size_t)row * 2048 + cat0 + lane * VPL;
#pragma unroll
        for (int j = 0; j < NP; ++j) { const u32x4 gw4 = cg[j]; const f32x4 n0 = ngr[2 * j], n1 = ngr[2 * j + 1];
            const f32x4 x0 = v[2 * j] * rs * n0, x1 = v[2 * j + 1] * rs * n1;
            float gv[8] = {bflo(gw4.x), bfhi(gw4.x), bflo(gw4.y), bfhi(gw4.y), bflo(gw4.z), bfhi(gw4.z), bflo(gw4.w), bfhi(gw4.w)};
            float r[8];
#pragma unroll
            for (int e = 0; e < 4; ++e) { r[e] = x0[e] * gv[e] * sigmoidf_(gv[e]); r[4 + e] = x1[e] * gv[4 + e] * sigmoidf_(gv[4 + e]); }
            *(u32x4*)(cp + 8 * j) = (u32x4){pk2(r[0], r[1]), pk2(r[2], r[3]), pk2(r[4], r[5]), pk2(r[6], r[7])}; }
    };
    for (int row = gw; row < M; row += 2 * NGW) {
        process(row, paA, pbA, pgA);
        if (row + NGW < M) process(row + NGW, paB, pbB, pgB);
    }
#undef POST_FETCH
}

#ifndef TAIL_CONV
#define TAIL_CONV 0
#endif
constexpr int EVEN_SHARED = 12544;
constexpr int TQ_IE = 64 * 8 * 6, TQ_IO = 80 * 8 * 6, TQ_UP = 104 * 8 * 6;
typedef __attribute__((address_space(1))) unsigned char GU8;
constexpr int PH_PER_LAYER = 9, NPHASES = 1 + 4 * PH_PER_LAYER + 1;
__global__ void __launch_bounds__(NWAVES * 64, 2) fwd_kernel(Args args) {
    extern __shared__ __attribute__((aligned(16))) unsigned char lds_raw[];
    LAS unsigned char* lds = (LAS unsigned char*)lds_raw;
    volatile LAS unsigned* MISC = (volatile LAS unsigned*)(lds + MISC_OFF);
    const int lo = args.ph_lo, hi = args.ph_hi;
    const int wave0 = __builtin_amdgcn_readfirstlane((int)threadIdx.x >> 6);
    for (int u = threadIdx.x; u < (LDS_BYTES - MISC_OFF) / 4; u += NWAVES * 64) MISC[u] = 0u;
    __syncthreads();
    XcdBarrier bar; bar.bar = (unsigned*)(args.ws + WS_CTL) + CW_BAR; bar.x = 0; bar.st = nullptr;
    if (hi - lo > 1) bar = xcd_barrier_post((unsigned*)(args.ws + WS_CTL) + CW_BAR, MISC + 8);
    int ph = 0;
#define PH_ON (ph >= lo && ph < hi)
#define PH_BEGIN GU8* wsg_ = (GU8*)args.ws; asm volatile("" : "+s"(wsg_)); unsigned char* ws = (unsigned char*)wsg_; unsigned mb_ = ~0u; asm volatile("" : "+s"(mb_)); int tid = wave0 * 64 + (int)__builtin_amdgcn_mbcnt_hi(mb_, __builtin_amdgcn_mbcnt_lo(mb_, 0u)); int bid = blockIdx.x; asm volatile("" : "+s"(bid)); int G = gridDim.x; asm volatile("" : "+s"(G)); const int lane = tid & 63, wave = __builtin_amdgcn_readfirstlane(tid >> 6); (void)lane; (void)wave; \
    bf16* X = (bf16*)(ws + WS_X); bf16* H = (bf16*)(ws + WS_H); float* MOD = (float*)(ws + WS_MOD); bf16* PROJ = (bf16*)(ws + WS_PROJ); bf16* CAT = (bf16*)(ws + WS_CAT); (void)X; (void)H; (void)MOD; (void)PROJ; (void)CAT;
#define PH_END do { if (ph + 1 < hi) { XcdBarrier b2 = bar; asm volatile("" : "+s"(b2.bar), "+s"(b2.x)); xcd_barrier(b2); } } while (0)

    if (PH_ON) { PH_BEGIN REP(1) { __syncthreads(); p0_prologue(args, ws, lds, tid, lane, wave, G, bid); } PH_END; } ++ph;

    for (int l = 0; l < 4; ++l) {
        const int li = l >> 1; const bool odd = (l & 1) != 0;
        if (PH_ON) { PH_BEGIN const float* modl = MOD + (size_t)l * 3 * 12288;
            if (l == 0) norm_phase<0, false>(args.in[I_XP], args.in[I_XS], nullptr, args.in[I_N1G] + (size_t)l * D, modl + 0 * D, modl + 1 * D, H, nullptr, lane, wave, G, bid);
            else norm_phase<0, true>(nullptr, nullptr, X, args.in[I_N1G] + (size_t)l * D, modl + 0 * D, modl + 1 * D, H, nullptr, lane, wave, G, bid); PH_END; } ++ph;
        if (PH_ON) { PH_BEGIN
            const int Nn = odd ? ODD_INP : EVEN_IN;
            pg8::Gemm g{H, (const bf16*)(ws + (odd ? WS_WOIN : WS_WEIN)) + (size_t)li * Nn * 2048, M, Nn, D, D, D, 0}; pg8::StaticOrder S; S.init(M, Nn, G, bid);
            pg8::EpiBf16 E{PROJ, Nn, (float*)(ws + WS_Z1), odd ? 24 : -1}; REP(3) pg8::gemm_phase<pg8::EpiBf16, pg8::StaticOrder, true>(lds, g, S, E, tid);
            if (TAIL_CONV && !CONV_IN_PROLOGUE && l < 3) { PH_BEGIN const int nwg_ = (M / 256) * ((odd ? ODD_INP : EVEN_IN) / 256), busy = nwg_ - ((nwg_ + 255) / 256 - 1) * 256;
                if (G == 256 && bid >= busy) { const int lo_ = l == 0 ? 0 : (l == 1 ? 0 : TQ_IO + TQ_UP), n_ = odd ? TQ_IO : TQ_IE;
                    convert_layer(args, ws, (LAS float*)(lds + wave * 16384), l == 0 ? 0 : 2, 2, lo_, lo_ + n_, false, (bid - busy) * NWAVES + wave, (G - busy) * NWAVES, lane, 0, 1); } }
            PH_END; } ++ph;
        if (PH_ON) { PH_BEGIN REP(4) { __syncthreads(); if (!odd) prep_ret(args, ws, lds, li, tid, lane, wave, G, bid); else prep_gla(args, ws, lds, li, tid, lane, wave, G, bid); } PH_END; } ++ph;
        if (PH_ON) { PH_BEGIN
            if (!odd) {
                REP(5) { __syncthreads(); scan_phase<128, 8, 128>(ws, lds, li, args.in[I_SRET], args.out + OUT_SR, tid, lane, wave, G, bid); }
                __syncthreads();
                pg8::Gemm g{(const bf16*)(ws + WS_POOLED), (const bf16*)(ws + WS_WPOOL) + (size_t)li * 4 * 65536, M, 1024, 256, 1024, 256, 512};
                pg8::EpiBf16 E{CAT, 2048, nullptr, -1};
                pg8::StaticOrder S; S.init(M, 1024, G, (bid + G - (G >= 256 ? 64 : 0)) % G);
                pg8::gemm_phase<pg8::EpiBf16, pg8::StaticOrder, true>(lds, g, S, E, tid);
            } else REP(5) { __syncthreads(); scan_phase<256, 4, 512>(ws, lds, li, args.in[I_SGLA], args.out + OUT_SG, tid, lane, wave, G, bid); }
            if (!CONV_IN_PROLOGUE) { PH_BEGIN
                const int nlong = odd ? 128 : 64, nl = G > nlong ? nlong : 0;
                __syncthreads();
                const bool tails = TAIL_CONV && G == 256;
                const int p2lo = !tails ? 0 : (l == 0 ? TQ_IE : (l == 2 ? TQ_IO + TQ_UP + TQ_IE : 0)), p1lo = (tails && !odd) ? TQ_UP : 0;
                const int xs = (!odd && !tails && nl > 0) ? EVEN_SHARED : p2lo;
                if (xs > p2lo) convert_layer(args, ws, (LAS float*)(lds + wave * 16384), l, 2, p2lo, xs, false, bid * NWAVES + wave, G * NWAVES, lane, 0, 1);
                if (bid >= nl) { convert_layer(args, ws, (LAS float*)(lds + wave * 16384), l, 2, xs, 1 << 30, false, (bid - nl) * NWAVES + wave, (G - nl) * NWAVES, lane, (bid - nl) * 512 + tid, (G - nl) * 512);
                    if (l < 3) convert_layer(args, ws, (LAS float*)(lds + wave * 16384), l + 1, 1, p1lo, 1 << 30, true, (bid - nl) * NWAVES + wave, (G - nl) * NWAVES, lane, (bid - nl) * 512 + tid, (G - nl) * 512); } }
            PH_END; } ++ph;
        if (PH_ON) { PH_BEGIN REP(6) if (!odd) post_phase<1024, 128>(ws, args.in[I_RNG] + (size_t)li * 1024, EVEN_IN, 1024, lane, wave, G, bid); else post_phase<2048, 512>(ws, args.in[I_GNG] + (size_t)li * 2048, ODD_INP, 0, lane, wave, G, bid); PH_END; } ++ph;
        if (PH_ON) { PH_BEGIN const float* modl = MOD + (size_t)l * 3 * 12288;
            pg8::Gemm g{CAT, (const bf16*)(ws + (odd ? WS_WOOUT : WS_WEOUT)) + (size_t)li * 2048 * 2048, M, D, D, D, D, 0};
            pg8::EpiResid E{args.in[I_XP], args.in[I_XS], l == 0, args.dry ? (bf16*)(ws + WS_UP) : X, modl + 2 * D, ws, (LAS unsigned*)(lds + 131072), 2 * l, 2 * l + 8 * args.dry};
            pg8::SplitOrder S; S.init(M, D, G, bid); S.Kh = D / 2; pg8::gemm_phase<pg8::EpiResid, pg8::SplitOrder, true>(lds, g, S, E, tid);
            PH_END; } ++ph;
        if (PH_ON) { PH_BEGIN const float* modl = MOD + (size_t)l * 3 * 12288;
            norm_phase<0, true>(nullptr, nullptr, X, args.in[I_N2G] + (size_t)l * D, modl + 3 * D, modl + 4 * D, H, nullptr, lane, wave, G, bid); PH_END; } ++ph;
        if (PH_ON) { PH_BEGIN
#if PROBE_LAUNCH_DUP == 28
            const int Kup = args.dry ? D / 2 : D;
#else
            constexpr int Kup = D;
#endif
            pg8::Gemm g{H, (const bf16*)(ws + WS_WUP) + (size_t)l * NUP * 2048, 50 * 256, NUP, Kup, D, D, 0}; pg8::UpOrder S; S.init(50 * 256, NUP, G, bid);
            pg8::EpiUpConv E{(bf16*)(ws + WS_ACT), args.in[I_CONVW] + (size_t)l * 3 * FF, args.in[I_CONVB] + (size_t)l * FF, (LAS float*)(lds + 131072)};
            REP(7) pg8::gemm_phase<pg8::EpiUpConv, pg8::UpOrder, true>(lds, g, S, E, tid);
            if (TAIL_CONV && !CONV_IN_PROLOGUE && l < 3) { PH_BEGIN constexpr int nwg_ = 50 * (NUP / 256), busy = nwg_ - ((nwg_ + 255) / 256 - 1) * 256;
                if (G == 256 && bid >= busy) { const int lo_ = odd ? TQ_IO : 0;
                    convert_layer(args, ws, (LAS float*)(lds + wave * 16384), odd ? 2 : l + 1, odd ? 2 : 1, lo_, lo_ + TQ_UP, false, (bid - busy) * NWAVES + wave, (G - busy) * NWAVES, lane, 0, 1); } }
            PH_END; } ++ph;
        if (PH_ON) { PH_BEGIN const float* modl = MOD + (size_t)l * 3 * 12288;
            pg8::Gemm g{(const bf16*)(ws + WS_ACT), (const bf16*)(ws + WS_WDN) + (size_t)l * 2048 * FF, M, D, FF, FF, FF, 0};
            pg8::EpiResid E{nullptr, nullptr, false, args.dry ? (bf16*)(ws + WS_UP) : X, modl + 5 * D, ws, (LAS unsigned*)(lds + 131072), 2 * l + 1, 2 * l + 1 + 8 * args.dry};
            pg8::SplitOrder S; S.init(M, D, G, bid); S.Kh = FF / 2; pg8::gemm_phase<pg8::EpiResid, pg8::SplitOrder, true>(lds, g, S, E, tid);
            PH_END; } ++ph;
    }
    if (PH_ON) { PH_BEGIN norm_phase<1, true>(nullptr, nullptr, X, args.in[I_FING], nullptr, nullptr, nullptr, args.out, lane, wave, G, bid); } ++ph;
#undef PH_ON
#undef PH_BEGIN
#undef PH_END
}

extern "C" void kernel_launch(void* const* d_in, const int* in_sizes, int n_in, void* d_out, int out_size, void* d_ws, size_t ws_size, hipStream_t stream) {
    static int grid = 0;
    if (grid == 0) {
        if (n_in != N_IN || ws_size < WS_END2) { fprintf(stderr, "kernel_launch: expected %d inputs and >= %zu bytes of workspace; got %d, %zu; nothing launched\n", (int)N_IN, (size_t)WS_END2, n_in, ws_size); grid = -1; return; }
        int dev = 0, cus = 0, per_cu = 0;
        if (hipGetDevice(&dev) != hipSuccess || hipDeviceGetAttribute(&cus, hipDeviceAttributeMultiprocessorCount, dev) != hipSuccess) { fprintf(stderr, "kernel_launch: device query failed\n"); grid = -1; return; }
        if (hipFuncSetAttribute((const void*)fwd_kernel, hipFuncAttributeMaxDynamicSharedMemorySize, LDS_BYTES) != hipSuccess) { fprintf(stderr, "kernel_launch: hipFuncSetAttribute failed\n"); grid = -1; return; }
        if (hipOccupancyMaxActiveBlocksPerMultiprocessor(&per_cu, (const void*)fwd_kernel, NWAVES * 64, LDS_BYTES) != hipSuccess || per_cu < 1)
            fprintf(stderr, "kernel_launch: note: occupancy query reports %d workgroups per CU\n", per_cu);
        (void)hipGetLastError();
        grid = cus;
    }
    if (grid < 0) return;
    (void)in_sizes; (void)out_size;
    if (hipMemsetAsync((char*)d_ws + WS_CTL, 0, CTL_ZERO_BYTES, stream) != hipSuccess) { fprintf(stderr, "kernel_launch: memset failed\n"); return; }
    Args a{};
    for (int i = 0; i < N_IN; ++i) a.in[i] = (const float*)d_in[i];
    a.out = (float*)d_out; a.ws = (unsigned char*)d_ws;
#if defined(PROBE_LAUNCH_DUP) && PROBE_LAUNCH_DUP
    for (int p = 0; p < NPHASES; ++p) { a.ph_lo = p; a.ph_hi = p + 1;
        const int cls = p == 0 ? 10 : (p == NPHASES - 1 ? 11 : (p - 1) % PH_PER_LAYER + 1);
        if (cls + 20 == PROBE_LAUNCH_DUP) { a.dry = 1; hipLaunchKernelGGL(fwd_kernel, dim3(grid), dim3(NWAVES * 64), LDS_BYTES, stream, a); a.dry = 0; }
        hipLaunchKernelGGL(fwd_kernel, dim3(grid), dim3(NWAVES * 64), LDS_BYTES, stream, a);
        if (cls == PROBE_LAUNCH_DUP) hipLaunchKernelGGL(fwd_kernel, dim3(grid), dim3(NWAVES * 64), LDS_BYTES, stream, a); }
#elif MK_ONE_LAUNCH
    a.ph_lo = 0; a.ph_hi = NPHASES;
    hipLaunchKernelGGL(fwd_kernel, dim3(grid), dim3(NWAVES * 64), LDS_BYTES, stream, a);
#else
    for (int p = 0; p < NPHASES; ++p) { a.ph_lo = p; a.ph_hi = p + 1; hipLaunchKernelGGL(fwd_kernel, dim3(grid), dim3(NWAVES * 64), LDS_BYTES, stream, a); }
#endif
    const hipError_t le = hipPeekAtLastError();
    if (le != hipSuccess) fprintf(stderr, "kernel_launch: launch failed: %s\n", hipGetErrorName(le));
}
```
